# Optimizing an MI355X kernel written in HIP

```python
import math
import jax, jax.numpy as jnp
from jax import lax
import numpy as np

D_MODEL = 2048
BATCH = 4
SEQ = 8192
DEPTH = 1

HEAD_DIM = 128
N_HEADS_MOBA = D_MODEL // (2 * HEAD_DIM)
N_HEADS_NSA = D_MODEL // (2 * HEAD_DIM)
NSA_KV_HEADS = 2
N_HEADS_TOTAL = N_HEADS_MOBA + N_HEADS_NSA
MOBA_BLOCK = 256
MOBA_TOPK = 3
MOBA_Q_CHUNK = 16
CMP_LEN = 32
CMP_STRIDE = 16
CMP_HIDDEN = HEAD_DIM
SLC_BLOCK = 64
SLC_TOPK = 16
WINDOW = 512
NSA_Q_CHUNK = 32
N_EXPERTS = 64
N_GROUPS = 8
TOPK_GROUPS = 4
TOP_K = 8
D_EXPERT = 512
ROUTED_SCALE = 2.5
EXPERT_CHUNK = 256
PLE_DIM = 256
RMS_EPS = 1e-6

COL_SPLITS = [
    N_HEADS_MOBA * HEAD_DIM, N_HEADS_MOBA * HEAD_DIM, N_HEADS_MOBA * HEAD_DIM,
    N_HEADS_NSA * HEAD_DIM,
    NSA_KV_HEADS * HEAD_DIM, NSA_KV_HEADS * HEAD_DIM,
    NSA_KV_HEADS * HEAD_DIM, NSA_KV_HEADS * HEAD_DIM,
    NSA_KV_HEADS * HEAD_DIM, NSA_KV_HEADS * HEAD_DIM,
    N_HEADS_NSA * 3,
]
D_IN = sum(COL_SPLITS)

kernel_name = "hybrid_moba_nsa_moe_ple_block"


def rms_norm(x, g):
    xf = x.astype(jnp.float32)
    y = xf * lax.rsqrt(jnp.mean(xf * xf, axis=-1, keepdims=True) + RMS_EPS)
    return (y * g.astype(jnp.float32)).astype(x.dtype)


def masked_softmax(s, mask):
    s = jnp.where(mask, s.astype(jnp.float32), -jnp.inf)
    m = jnp.max(s, axis=-1, keepdims=True)
    m = jnp.where(jnp.isfinite(m), m, 0.0)
    e = jnp.where(mask, jnp.exp(s - m), 0.0)
    return e / jnp.maximum(jnp.sum(e, axis=-1, keepdims=True), 1e-30)


def alibi_slopes(n):
    return jnp.asarray(2.0 ** (-8.0 * np.arange(1, n + 1) / n), dtype=jnp.float32)


def moba_attention(q, k, v, slopes):
    B, T, H, d = q.shape
    nb = -(-T // MOBA_BLOCK)
    Tp = nb * MOBA_BLOCK
    pad = ((0, 0), (0, Tp - T), (0, 0), (0, 0))
    q, k, v = [jnp.pad(a, pad).transpose(0, 2, 1, 3) for a in (q, k, v)]
    kb = k.reshape(B, H, nb, MOBA_BLOCK, d)
    vb = v.reshape(B, H, nb, MOBA_BLOCK, d)
    kmean = jnp.mean(kb.astype(jnp.float32), axis=3)
    scale = d ** -0.5
    slope = slopes[None, :, None, None]
    bi = jnp.arange(B)[:, None, None, None]
    hi = jnp.arange(H)[None, :, None, None]
    n_sel = min(MOBA_TOPK, nb)
    QC = MOBA_Q_CHUNK
    blk_pos = jnp.arange(MOBA_BLOCK)

    def chunk(c):
        t0 = c * QC
        t = t0 + jnp.arange(QC)
        bt = t0 // MOBA_BLOCK
        qc = lax.dynamic_slice_in_dim(q, t0, QC, axis=2).astype(jnp.float32)
        gate = jnp.einsum('bhqd,bhnd->bhqn', qc, kmean)
        gate = jnp.where(jnp.arange(nb) < bt, gate, -jnp.inf)
        gsc, idx = lax.top_k(gate, n_sel)
        sel_valid = gsc > -jnp.inf
        k_sel = kb[bi, hi, idx].astype(jnp.float32)
        v_sel = vb[bi, hi, idx].reshape(B, H, QC, n_sel * MOBA_BLOCK, d)
        s_sel = jnp.einsum('bhqd,bhqnkd->bhqnk', qc, k_sel) * scale
        pos_sel = idx[..., None] * MOBA_BLOCK + blk_pos
        s_sel = s_sel - slope[..., None] * (t[:, None, None] - pos_sel)
        s_sel = s_sel.reshape(B, H, QC, n_sel * MOBA_BLOCK)
        m_sel = jnp.broadcast_to(sel_valid[..., None], (B, H, QC, n_sel, MOBA_BLOCK))
        m_sel = m_sel.reshape(B, H, QC, n_sel * MOBA_BLOCK)
        k_own = lax.dynamic_slice_in_dim(k, bt * MOBA_BLOCK, MOBA_BLOCK, axis=2).astype(jnp.float32)
        v_own = lax.dynamic_slice_in_dim(v, bt * MOBA_BLOCK, MOBA_BLOCK, axis=2)
        pos_own = bt * MOBA_BLOCK + blk_pos
        s_own = jnp.einsum('bhqd,bhkd->bhqk', qc, k_own) * scale
        s_own = s_own - slope * (t[:, None] - pos_own[None, :])
        m_own = jnp.broadcast_to(pos_own[None, :] <= t[:, None], (B, H, QC, MOBA_BLOCK))
        probs = masked_softmax(jnp.concatenate([s_sel, s_own], axis=-1),
                               jnp.concatenate([m_sel, m_own], axis=-1))
        ns = n_sel * MOBA_BLOCK
        o = (jnp.einsum('bhqk,bhqkd->bhqd', probs[..., :ns], v_sel)
             + jnp.einsum('bhqk,bhkd->bhqd', probs[..., ns:], v_own))
        return o.astype(q.dtype)

    out = lax.map(chunk, jnp.arange(Tp // QC))
    return out.transpose(1, 0, 3, 2, 4).reshape(B, Tp, H, d)[:, :T]


def compress_tokens(a, pos, w1, w2):
    B, T, G, d = a.shape
    nc = (T - CMP_LEN) // CMP_STRIDE + 1
    idx = jnp.arange(nc)[:, None] * CMP_STRIDE + jnp.arange(CMP_LEN)[None, :]
    blk = a[:, idx] + pos[None, None, :, None, :]
    flat = blk.transpose(0, 1, 3, 2, 4).reshape(B, nc, G, CMP_LEN * d)
    hid = jax.nn.gelu(flat @ w1)
    return (hid @ w2).transpose(0, 2, 1, 3)


def nsa_attention(q, kc, vc, ks, vs, kw, vw, gates, slopes,
                  pos_k, w1_k, w2_k, pos_v, w1_v, w2_v):
    B, T, H, d = q.shape
    G = kc.shape[2]
    R = H // G
    scale = d ** -0.5
    QC = NSA_Q_CHUNK
    k_cmp = compress_tokens(kc, pos_k, w1_k, w2_k).astype(jnp.float32)
    v_cmp = compress_tokens(vc, pos_v, w1_v, w2_v)
    nc = k_cmp.shape[2]
    cstart = jnp.arange(nc) * CMP_STRIDE
    cend = cstart + CMP_LEN - 1
    ns = T // SLC_BLOCK
    n_slc = min(SLC_TOPK, ns)
    sstart = jnp.arange(ns) * SLC_BLOCK
    overlap = ((cend[:, None] >= sstart[None, :]) &
               (cstart[:, None] <= sstart[None, :] + SLC_BLOCK - 1)).astype(jnp.float32)
    ks_blk = ks.transpose(0, 2, 1, 3).reshape(B, G, ns, SLC_BLOCK, d)
    vs_blk = vs.transpose(0, 2, 1, 3).reshape(B, G, ns, SLC_BLOCK, d)
    kw_p = jnp.pad(kw.transpose(0, 2, 1, 3), ((0, 0), (0, 0), (WINDOW, 0), (0, 0)))
    vw_p = jnp.pad(vw.transpose(0, 2, 1, 3), ((0, 0), (0, 0), (WINDOW, 0), (0, 0)))
    qg = q.reshape(B, T, G, R, d).transpose(0, 2, 3, 1, 4)
    gg = gates.reshape(B, T, G, R, 3).transpose(0, 2, 3, 1, 4)
    slope = slopes.reshape(G, R)[None, :, :, None, None]
    bi = jnp.arange(B)[:, None, None, None]
    gi = jnp.arange(G)[None, :, None, None]
    blk_id = jnp.arange(ns)
    slc_pos = jnp.arange(SLC_BLOCK)
    win_off = jnp.arange(WINDOW + QC)

    def chunk(c):
        t0 = c * QC
        t = t0 + jnp.arange(QC)
        qc = lax.dynamic_slice_in_dim(qg, t0, QC, axis=3).astype(jnp.float32)
        s_c = jnp.einsum('bgrqd,bgnd->bgrqn', qc, k_cmp) * scale
        s_c = s_c - slope * (t[:, None] - cend[None, :])
        p_c = masked_softmax(s_c, cend[None, :] <= t[:, None])
        o_c = jnp.einsum('bgrqn,bgnd->bgrqd', p_c, v_cmp)
        imp = jnp.einsum('bgrqn,ns->bgqs', p_c, overlap)
        bt = t // SLC_BLOCK
        forced = ((blk_id[None, :] == 0) | (blk_id[None, :] == bt[:, None]) |
                  (blk_id[None, :] == bt[:, None] - 1))
        pri = jnp.where(blk_id[None, :] > bt[:, None], -jnp.inf,
                        jnp.where(forced, jnp.inf, imp))
        psc, idx = lax.top_k(pri, n_slc)
        valid = psc > -jnp.inf
        k_sel = ks_blk[bi, gi, idx].astype(jnp.float32)
        v_sel = vs_blk[bi, gi, idx].reshape(B, G, QC, n_slc * SLC_BLOCK, d)
        s_s = jnp.einsum('bgrqd,bgqnkd->bgrqnk', qc, k_sel) * scale
        pos_s = idx[..., None] * SLC_BLOCK + slc_pos
        dist_s = (t[:, None, None] - pos_s)[:, :, None]
        s_s = s_s - slope[..., None] * dist_s
        m_s = (valid[..., None] & (pos_s <= t[:, None, None]))[:, :, None]
        m_s = jnp.broadcast_to(m_s, s_s.shape).reshape(B, G, R, QC, n_slc * SLC_BLOCK)
        p_s = masked_softmax(s_s.reshape(B, G, R, QC, n_slc * SLC_BLOCK), m_s)
        o_s = jnp.einsum('bgrqk,bgqkd->bgrqd', p_s, v_sel)
        kwc = lax.dynamic_slice_in_dim(kw_p, t0, WINDOW + QC, axis=2).astype(jnp.float32)
        vwc = lax.dynamic_slice_in_dim(vw_p, t0, WINDOW + QC, axis=2)
        pos_w = t0 - WINDOW + win_off
        s_w = jnp.einsum('bgrqd,bgkd->bgrqk', qc, kwc) * scale
        s_w = s_w - slope * (t[:, None] - pos_w[None, :])
        m_w = ((pos_w[None, :] >= 0) & (pos_w[None, :] <= t[:, None]) &
               (t[:, None] - pos_w[None, :] < WINDOW))
        p_w = masked_softmax(s_w, m_w)
        o_w = jnp.einsum('bgrqk,bgkd->bgrqd', p_w, vwc)
        g = lax.dynamic_slice_in_dim(gg, t0, QC, axis=3).astype(jnp.float32)
        o = g[..., 0:1] * o_c + g[..., 1:2] * o_s + g[..., 2:3] * o_w
        return o.astype(q.dtype)

    out = lax.map(chunk, jnp.arange(T // QC))
    return out.transpose(1, 0, 4, 2, 3, 5).reshape(B, T, H, d)


def swiglu(h, wg, wu, wd):
    return (jax.nn.silu(h @ wg) * (h @ wu)) @ wd


def moe_ffn(h, w_router, router_bias, w_gate_e, w_up_e, w_down_e, w_gate_s, w_up_s, w_down_s):
    B, T, D = h.shape
    N = B * T
    hf = h.reshape(N, D)
    aff = jax.nn.sigmoid((hf @ w_router).astype(jnp.float32))
    biased = aff + router_bias.astype(jnp.float32)
    gscore = jnp.sum(lax.top_k(biased.reshape(N, N_GROUPS, N_EXPERTS // N_GROUPS), 2)[0], axis=-1)
    _, gidx = lax.top_k(gscore, TOPK_GROUPS)
    gmask = jnp.any(gidx[..., None] == jnp.arange(N_GROUPS), axis=-2)
    emask = jnp.repeat(gmask, N_EXPERTS // N_GROUPS, axis=1)
    _, eidx = lax.top_k(jnp.where(emask, biased, -jnp.inf), TOP_K)
    w = jnp.take_along_axis(aff, eidx, axis=1)
    w = w / jnp.sum(w, axis=-1, keepdims=True) * ROUTED_SCALE
    NK = N * TOP_K
    C = EXPERT_CHUNK
    flat_e = eidx.reshape(NK)
    flat_tok = jnp.arange(NK, dtype=jnp.int32) // TOP_K
    flat_w = w.reshape(NK)
    order = jnp.argsort(flat_e)
    se, stok, sw = flat_e[order], flat_tok[order], flat_w[order]
    counts = jnp.zeros((N_EXPERTS,), jnp.int32).at[flat_e].add(1)
    start = jnp.cumsum(counts) - counts
    pcounts = (counts + C - 1) // C * C
    pend = jnp.cumsum(pcounts)
    pstart = pend - pcounts
    dest = pstart[se] + (jnp.arange(NK, dtype=jnp.int32) - start[se])
    n_chunks = -(-(NK + N_EXPERTS * (C - 1)) // C)
    P = n_chunks * C
    buf_tok = jnp.full((P,), N, jnp.int32).at[dest].set(stok)
    buf_w = jnp.zeros((P,), jnp.float32).at[dest].set(sw)
    chunk_e = jnp.minimum(jnp.searchsorted(pend, jnp.arange(n_chunks, dtype=jnp.int32) * C,
                                           side='right'), N_EXPERTS - 1)
    h_pad = jnp.concatenate([hf, jnp.zeros((1, D), hf.dtype)], axis=0)

    def expert_chunk(acc, c):
        tok = lax.dynamic_slice_in_dim(buf_tok, c * C, C)
        wt = lax.dynamic_slice_in_dim(buf_w, c * C, C)
        e = chunk_e[c]
        y = swiglu(h_pad[tok], w_gate_e[e], w_up_e[e], w_down_e[e])
        return acc.at[tok].add(y.astype(jnp.float32) * wt[:, None]), None

    acc, _ = lax.scan(expert_chunk, jnp.zeros((N + 1, D), jnp.float32), jnp.arange(n_chunks))
    routed = acc[:N].astype(h.dtype)
    shared = swiglu(hf, w_gate_s, w_up_s, w_down_s)
    return (routed + shared).reshape(B, T, D)


def setup_inputs(seed: int = 0) -> dict:
    key = jax.random.key(seed)
    ks = jax.random.split(key, 32)
    f32 = jnp.float32
    L, D, d, G = DEPTH, D_MODEL, HEAD_DIM, NSA_KV_HEADS
    D_MOBA = N_HEADS_MOBA * HEAD_DIM
    D_NSA = N_HEADS_NSA * HEAD_DIM

    def nrm(k, shape, scale):
        return jax.random.normal(k, shape, f32) * scale

    def gain(k, shape):
        return 1.0 + 0.02 * jax.random.normal(k, shape, f32)

    return {
        "x": nrm(ks[0], (BATCH, SEQ, D), 1.0),
        "p": nrm(ks[1], (L, BATCH, SEQ, PLE_DIM), 1.0),
        "norm_mix_g": gain(ks[2], (L, D)),
        "w_in": nrm(ks[3], (L, D, D_IN), D ** -0.5),
        "moba_out_g": gain(ks[4], (L, D_MOBA)),
        "nsa_out_g": gain(ks[5], (L, D_NSA)),
        "cmp_pos_k": nrm(ks[6], (L, CMP_LEN, d), 0.02),
        "cmp_w1_k": nrm(ks[7], (L, CMP_LEN * d, CMP_HIDDEN), (CMP_LEN * d) ** -0.5),
        "cmp_w2_k": nrm(ks[8], (L, CMP_HIDDEN, d), CMP_HIDDEN ** -0.5),
        "cmp_pos_v": nrm(ks[9], (L, CMP_LEN, d), 0.02),
        "cmp_w1_v": nrm(ks[10], (L, CMP_LEN * d, CMP_HIDDEN), (CMP_LEN * d) ** -0.5),
        "cmp_w2_v": nrm(ks[11], (L, CMP_HIDDEN, d), CMP_HIDDEN ** -0.5),
        "w_out": nrm(ks[12], (L, D_MOBA + D_NSA, D), (D_MOBA + D_NSA) ** -0.5),
        "norm_ffn_g": gain(ks[13], (L, D)),
        "w_router": nrm(ks[14], (L, D, N_EXPERTS), D ** -0.5),
        "router_bias": nrm(ks[15], (L, N_EXPERTS), 0.01),
        "w_gate_e": nrm(ks[16], (L, N_EXPERTS, D, D_EXPERT), D ** -0.5),
        "w_up_e": nrm(ks[17], (L, N_EXPERTS, D, D_EXPERT), D ** -0.5),
        "w_down_e": nrm(ks[18], (L, N_EXPERTS, D_EXPERT, D), D_EXPERT ** -0.5),
        "w_gate_s": nrm(ks[19], (L, D, D_EXPERT), D ** -0.5),
        "w_up_s": nrm(ks[20], (L, D, D_EXPERT), D ** -0.5),
        "w_down_s": nrm(ks[21], (L, D_EXPERT, D), D_EXPERT ** -0.5),
        "norm_ple_g": gain(ks[22], (L, D)),
        "w_ple": nrm(ks[23], (L, PLE_DIM, D), PLE_DIM ** -0.5),
        "w_ple_gate": nrm(ks[24], (L, D, D), D ** -0.5),
        "norm_final_g": gain(ks[25], (D,)),
    }


def reference(x, p, norm_mix_g, w_in, moba_out_g, nsa_out_g,
              cmp_pos_k, cmp_w1_k, cmp_w2_k, cmp_pos_v, cmp_w1_v, cmp_w2_v,
              w_out, norm_ffn_g, w_router, router_bias,
              w_gate_e, w_up_e, w_down_e, w_gate_s, w_up_s, w_down_s,
              norm_ple_g, w_ple, w_ple_gate, norm_final_g):
    B, T, _ = x.shape
    slopes = alibi_slopes(N_HEADS_TOTAL)
    moba_slopes = slopes[0::2]
    nsa_slopes = slopes[1::2]
    split_at = [int(s) for s in np.cumsum(COL_SPLITS)[:-1]]
    for i in range(DEPTH):
        h = rms_norm(x, norm_mix_g[i])
        proj = h @ w_in[i]
        mq, mk, mv, nq, kc, vc, ksl, vsl, kwn, vwn, ng = jnp.split(proj, split_at, axis=-1)
        hm = lambda a: a.reshape(B, T, N_HEADS_MOBA, HEAD_DIM)
        hk = lambda a: a.reshape(B, T, NSA_KV_HEADS, HEAD_DIM)
        o_m = moba_attention(hm(mq), hm(mk), hm(mv), moba_slopes)
        gates = jax.nn.sigmoid(ng.astype(jnp.float32)).reshape(B, T, N_HEADS_NSA, 3)
        o_n = nsa_attention(nq.reshape(B, T, N_HEADS_NSA, HEAD_DIM),
                            hk(kc), hk(vc), hk(ksl), hk(vsl), hk(kwn), hk(vwn),
                            gates, nsa_slopes,
                            cmp_pos_k[i], cmp_w1_k[i], cmp_w2_k[i],
                            cmp_pos_v[i], cmp_w1_v[i], cmp_w2_v[i])
        o_m = rms_norm(o_m.reshape(B, T, -1), moba_out_g[i])
        o_n = rms_norm(o_n.reshape(B, T, -1), nsa_out_g[i])
        x = x + jnp.concatenate([o_m, o_n], axis=-1) @ w_out[i]
        x = x + moe_ffn(rms_norm(x, norm_ffn_g[i]), w_router[i], router_bias[i],
                        w_gate_e[i], w_up_e[i], w_down_e[i],
                        w_gate_s[i], w_up_s[i], w_down_s[i])
        gate = jax.nn.sigmoid(rms_norm(x, norm_ple_g[i]) @ w_ple_gate[i])
        x = x + (p[i] @ w_ple[i]) * gate
    return rms_norm(x, norm_final_g)
```

```cpp
#include <hip/hip_runtime.h>
#include <cstdio>
#include <cstdint>

#define DI __device__ __forceinline__
#define GAS __attribute__((address_space(1)))
#define LAS __attribute__((address_space(3)))
typedef unsigned short bf16_t;
typedef short bf16x8 __attribute__((ext_vector_type(8)));
typedef short s16x4 __attribute__((ext_vector_type(4)));
typedef float f32x2 __attribute__((ext_vector_type(2)));
typedef float f32x4 __attribute__((ext_vector_type(4)));
typedef float f32x16 __attribute__((ext_vector_type(16)));
typedef unsigned u32x2 __attribute__((ext_vector_type(2)));
typedef unsigned u32x4 __attribute__((ext_vector_type(4)));
typedef __bf16 bf2_t __attribute__((ext_vector_type(2)));
typedef int v8i32 __attribute__((ext_vector_type(8)));
#ifndef F8GU
#define F8GU 1
#endif
#ifndef F8DN
#define F8DN 1
#endif
#ifndef F8G3
#define F8G3 0
#endif
#ifndef F8PLE
#define F8PLE 1
#endif
constexpr float WOUT_SCALE = F8G3 ? 64.f : 1.f, WPG_SCALE = F8PLE ? 64.f : 1.f;
constexpr float YP_SCALE = 16.f;
constexpr float WGU_SCALE = F8GU ? 64.f : 1.f, WD_SCALE = F8DN ? 32.f : 1.f;

constexpr int NB = 4, NT = 8192, DM = 2048, NTOK = NB * NT, HD = 128;
constexpr int DIN = 5656, DINP = 5888;
constexpr int NE = 64, DE = 512, PLE = 256;
constexpr float EPS = 1e-6f;
constexpr float LOG2E = 1.4426950408889634f;
constexpr float QSCALE = 0.08838834764831845f * LOG2E;
constexpr int NWAVES = 8, NTHR = 512;
constexpr int PSH = 278528;
constexpr int HROWS = PSH + NTOK;

constexpr size_t MiB = 1u << 20;
constexpr size_t WS_CTL = 0, CTL_BYTES = 4 * MiB;
constexpr size_t CTLW_BAR = 4096;
constexpr size_t CTLW_CNT = 16384;
constexpr size_t CTL_SSQ1 = 1 * MiB, CTL_SSQ3 = CTL_SSQ1 + 131072;
constexpr size_t WS_RS0 = 4 * MiB, WS_RS1 = WS_RS0 + 131072, WS_RS2 = WS_RS1 + 131072, WS_KMEAN = WS_RS2 + 131072  , WS_BIAS = WS_KMEAN + 262144  ;
constexpr size_t WS_KCMP = 5 * MiB, WS_VCMP = 6 * MiB;
constexpr size_t WS_GATES = 7 * MiB;
constexpr size_t WS_ASG = 10 * MiB;
constexpr size_t WS_PK = 12 * MiB, WS_PV = 16 * MiB;
constexpr size_t WS_TOKL = 20 * MiB, WS_WL = 28 * MiB, WS_RSL = 36 * MiB;
constexpr size_t WS_PB = 44 * MiB;
constexpr size_t WS_WPG = 60 * MiB, WS_WPLE = 68 * MiB, WS_WR = 69 * MiB, WS_W1K = 70 * MiB, WS_W1V = 71 * MiB;
constexpr size_t WS_WD = 72 * MiB;
constexpr size_t WS_WGU = 202 * MiB;
constexpr size_t WS_WIN = 462 * MiB;
constexpr size_t WS_WOUT = 485 * MiB;
constexpr size_t WS_HB = 493 * MiB;
constexpr size_t WS_PROJ = 621 * MiB;
constexpr size_t WS_MQ = WS_PROJ, WS_MK = WS_MQ + 64 * MiB, WS_MV = WS_MK + 64 * MiB, WS_NQ = WS_MV + 64 * MiB;
constexpr size_t WS_KC = WS_NQ + 64 * MiB, WS_VC = WS_KC + 16 * MiB, WS_KS = WS_VC + 16 * MiB, WS_VS = WS_KS + 16 * MiB, WS_KW = WS_VS + 16 * MiB, WS_VW = WS_KW + 16 * MiB;
constexpr size_t WS_H = WS_PROJ + 128 * MiB;
constexpr size_t WS_HB8 = WS_PROJ;
constexpr size_t WS_YP = WS_WGU;
constexpr size_t WS_X2B = WS_H;
constexpr size_t WS_X28 = WS_H + 128 * MiB;
constexpr size_t WS_PP = WS_H + 192 * MiB;
static_assert(F8DN == 1, "the workspace map below assumes e4m3 H (152 MiB)");
constexpr size_t WS_ML = 1054 * MiB;
constexpr size_t WS_LIST = 1062 * MiB;
constexpr size_t CTLW_Q3 = 28704;
constexpr size_t CTLW_Q4 = 28672;
constexpr size_t CTLW_ARR = 24576;
constexpr size_t CTLW_LCNT = 20480;
constexpr size_t WS_END = 1094 * MiB;
static_assert(WS_YP + (size_t)PSH * 2048 <= WS_H, "Yp must end below H");
static_assert(WS_H + (size_t)HROWS * 512 <= WS_X2B + 0 * MiB + 152 * MiB && WS_X28 + 64 * MiB <= WS_PP && WS_PP + 128 * MiB <= WS_END, "PP placement");
static_assert(WS_VW + 16 * MiB <= WS_END && WS_H + (size_t)HROWS * 1024 <= WS_ML && WS_END <= 1100 * MiB, "ws map");

DI unsigned pk4_f8(float a, float b, float c, float d) { unsigned w = 0u; w = __builtin_amdgcn_cvt_pk_fp8_f32(a, b, w, false); w = __builtin_amdgcn_cvt_pk_fp8_f32(c, d, w, true); return w; }
DI unsigned pk2(float lo, float hi) { f32x2 v = {lo, hi}; return __builtin_bit_cast(unsigned, __builtin_convertvector(v, bf2_t)); }
DI float bflo(unsigned u) { return __uint_as_float(u << 16); }
DI float bfhi(unsigned u) { return __uint_as_float(u & 0xffff0000u); }
DI float wave_sum(float v) {
#pragma unroll
    for (int o = 1; o < 64; o <<= 1) v += __shfl_xor(v, o);
    return v;
}
DI int lane_id_v() { int l; asm volatile("v_mbcnt_lo_u32_b32 %0, -1, 0\n\tv_mbcnt_hi_u32_b32 %0, -1, %0" : "=v"(l)); return l; }
#define LDS_WAIT() asm volatile("s_waitcnt lgkmcnt(0)" ::: "memory")
#define VM_WAIT() asm volatile("s_waitcnt vmcnt(0)" ::: "memory")

#define XB_TMO      128
#define XB_XCNT(j)  (256  + 64 * (j))
#define XB_XSUB(j)  (1280 + 64 * (j))
#define XB_XGEN(j)  (2304 + 64 * (j))
#define XB_TOP      3328
#define XB_TOPGEN   3392
#define XCD_BAR_WORDS 3456
#define XB_SPIN_CAP (1u << 18)
DI unsigned xb_ld(unsigned* p)              { return __hip_atomic_load(p, __ATOMIC_RELAXED, __HIP_MEMORY_SCOPE_AGENT); }
DI unsigned xb_add(unsigned* p, unsigned v) { return __hip_atomic_fetch_add(p, v, __ATOMIC_RELAXED, __HIP_MEMORY_SCOPE_AGENT); }
DI unsigned xb_xcc_id() { return (unsigned)__builtin_amdgcn_s_getreg((3 << 11) | 20) & 0xFu; }
#define XB_SPIN(cond, bar) do { unsigned _sp = 0; while (cond) { __builtin_amdgcn_s_sleep(1); \
    if ((++_sp & 255u) == 0u) { if (xb_ld(&(bar)[XB_TMO])) break; if (_sp > XB_SPIN_CAP) { atomicAdd(&(bar)[XB_TMO], 1u); break; } } } } while (0)
struct XcdBarrier { unsigned* bar; unsigned x; volatile LAS unsigned* st; };
DI XcdBarrier xcd_barrier_post(unsigned* bar, volatile LAS unsigned* st) {
    XcdBarrier b; b.bar = bar; b.x = xb_xcc_id(); b.st = st;
    if (threadIdx.x == 0) (void)xb_add(&bar[XB_XCNT(b.x)], 1u);
    return b;
}
DI void xcd_barrier_complete(unsigned* bar, unsigned x, unsigned& nloc, unsigned& nx) {
    const unsigned G = gridDim.x * gridDim.y * gridDim.z;
    unsigned sum, cnt, mine, sp = 0u;
    for (;;) {
        sum = 0u; cnt = 0u; mine = 0u;
#pragma unroll
        for (unsigned j = 0; j < 16; ++j) { const unsigned c = xb_ld(&bar[XB_XCNT(j)]); sum += c; cnt += (c > 0u) ? 1u : 0u; mine = (j == x) ? c : mine; }
        if (sum == G) break;
        __builtin_amdgcn_s_sleep(1);
        if ((++sp & 255u) == 0u) { if (xb_ld(&bar[XB_TMO])) break; if (sp > XB_SPIN_CAP) { atomicAdd(&bar[XB_TMO], 1u); break; } }
    }
    nloc = mine > 0u ? mine : 1u; nx = cnt > 0u ? cnt : 1u;
}
DI void xcd_barrier(const XcdBarrier& b) {
    asm volatile("s_waitcnt vmcnt(0)" ::: "memory");
    __syncthreads();
    if (threadIdx.x == 0) {
        unsigned* bar = b.bar;
        __builtin_amdgcn_s_waitcnt(0);
        unsigned nloc = b.st[0], nx = b.st[1];
        if (nloc == 0u) { xcd_barrier_complete(bar, b.x, nloc, nx); b.st[0] = nloc; b.st[1] = nx; }
        const unsigned old = xb_add(&bar[XB_XSUB(b.x)], 1u);
        const unsigned gen = old / nloc;
        if (old + 1u == (gen + 1u) * nloc) {
            __builtin_amdgcn_fence(__ATOMIC_RELEASE, "agent");
            asm volatile("s_waitcnt vmcnt(0)" ::: "memory");
            const unsigned og = xb_add(&bar[XB_TOP], 1u);
            const unsigned tg = og / nx;
            if (og + 1u == (tg + 1u) * nx) xb_add(&bar[XB_TOPGEN], 1u);
            else XB_SPIN(xb_ld(&bar[XB_TOPGEN]) == tg, bar);
            __builtin_amdgcn_fence(__ATOMIC_ACQUIRE, "agent");
            xb_add(&bar[XB_XGEN(b.x)], 1u);
            asm volatile("s_waitcnt vmcnt(0)" ::: "memory");
        } else {
            XB_SPIN(xb_ld(&bar[XB_XGEN(b.x)]) == gen, bar);
            __builtin_amdgcn_fence(__ATOMIC_ACQUIRE, "agent");
            asm volatile("s_waitcnt vmcnt(0)" ::: "memory");
        }
    }
    __syncthreads();
}

struct Args {
    const float* in[26];
    float* out; unsigned char* ws;
    int ph_lo, ph_hi;
};
enum { I_X = 0, I_P, I_NMIXG, I_WIN, I_MOBAG, I_NSAG, I_POSK, I_W1K, I_W2K, I_POSV, I_W1V, I_W2V, I_WOUT, I_NFFNG, I_WROUTER, I_RBIAS,
       I_WGE, I_WUE, I_WDE, I_WGS, I_WUS, I_WDS, I_NPLEG, I_WPLE, I_WPLEG, I_NFING };
DI void tr64(const float* src, int ldw, int nvalid, const float* gain, bf16_t* dst, int ldd, LAS float* scr, int lane) {
    const int c4 = (lane & 15) * 4, r0 = lane >> 4;
#pragma unroll 8
    for (int i = 0; i < 16; ++i) {
        const int kk = 4 * i + r0;
        f32x4 v = {0.f, 0.f, 0.f, 0.f};
        if (c4 < nvalid) v = *(const f32x4*)(src + (size_t)kk * ldw + c4);
        if (gain) { const float g = gain[kk]; v = v * g; }
        LAS float* s = scr + kk * 65 + c4;
        s[0] = v.x; s[1] = v.y; s[2] = v.z; s[3] = v.w;
    }
    LDS_WAIT();
    const int c = lane & 7, nr = lane >> 3;
#pragma unroll
    for (int j = 0; j < 8; ++j) {
        const int n = nr + 8 * j;
        const LAS float* s = scr + (8 * c) * 65 + n;
        u32x4 o; o.x = pk2(s[0 * 65], s[1 * 65]); o.y = pk2(s[2 * 65], s[3 * 65]); o.z = pk2(s[4 * 65], s[5 * 65]); o.w = pk2(s[6 * 65], s[7 * 65]);
        *(u32x4*)(dst + (size_t)n * ldd + 8 * c) = o;
    }
    LDS_WAIT();
}

DI void tr64_f8(const float* src, int ldw, const float* gain, float scale, unsigned char* dst, int ldd, LAS float* scr, int lane) {
    const int c4 = (lane & 15) * 4, r0 = lane >> 4;
#pragma unroll 8
    for (int i = 0; i < 16; ++i) {
        const int kk = 4 * i + r0;
        f32x4 v = *(const f32x4*)(src + (size_t)kk * ldw + c4);
        const float g = gain ? gain[kk] * scale : scale; v = v * g;
        LAS float* s = scr + kk * 65 + c4;
        s[0] = v.x; s[1] = v.y; s[2] = v.z; s[3] = v.w;
    }
    LDS_WAIT();
    const int c = lane & 7, nr = lane >> 3;
#pragma unroll
    for (int j = 0; j < 8; ++j) {
        const int n = nr + 8 * j;
        const LAS float* s = scr + (8 * c) * 65 + n;
        unsigned w0 = 0u, w1 = 0u;
        w0 = __builtin_amdgcn_cvt_pk_fp8_f32(s[0 * 65], s[1 * 65], w0, false); w0 = __builtin_amdgcn_cvt_pk_fp8_f32(s[2 * 65], s[3 * 65], w0, true);
        w1 = __builtin_amdgcn_cvt_pk_fp8_f32(s[4 * 65], s[5 * 65], w1, false); w1 = __builtin_amdgcn_cvt_pk_fp8_f32(s[6 * 65], s[7 * 65], w1, true);
        u32x2 o; o.x = w0; o.y = w1;
        *(u32x2*)(dst + (size_t)n * ldd + 8 * c) = o;
    }
    LDS_WAIT();
}

struct PArgs {
    float* out; unsigned char* ws;
    LAS unsigned char* lds; int tid, lane, wave, G, wg;
};
DI const float* INP(int i) {
    typedef __attribute__((address_space(4))) const char* kptr_t;
    kptr_t ka = (kptr_t)__builtin_amdgcn_kernarg_segment_ptr();
    asm volatile("" : "+s"(ka));
    const uintptr_t raw = *(__attribute__((address_space(4))) const uintptr_t*)(ka + 8 * i);
    const GAS float* g = (const GAS float*)raw;
    return (const float*)g;
}

struct TrItem { const float* src; int ldw; const float* gain; float scale; unsigned char* dst; int ldd; bool bf; };
DI void tr_expert_desc(const PArgs& P, int r, TrItem& d) {
    constexpr int I_EG = 65 * 256, I_EU = 65 * 256;
    unsigned char* ws = P.ws;
    d.bf = false;
    if (r < I_EG + I_EU) { const int up = r >= I_EG; if (up) r -= I_EG; const int e = r >> 8, q = r & 255, kb = q >> 3, nb = q & 7;
        const float* w = (e < 64) ? INP(up ? I_WUE : I_WGE) + (size_t)e * DM * DE : INP(up ? I_WUS : I_WGS);
        const int n0 = 64 * nb, drow = (n0 >> 7) * 256 + up * 128 + (n0 & 127);
        d.src = w + (size_t)(64 * kb) * DE + n0; d.ldw = DE; d.gain = INP(I_NFFNG) + 64 * kb; d.scale = WGU_SCALE; d.dst = ws + WS_WGU + ((size_t)e * 1024 + drow) * DM + 64 * kb; d.ldd = DM; return; }
    r -= I_EG + I_EU;
    { const int e = r >> 8, q = r & 255, kb = q >> 5, nb = q & 31;
        const float* w = (e < 64) ? INP(I_WDE) + (size_t)e * DE * DM : INP(I_WDS);
        if (e < 65) { d.src = w + (size_t)(64 * kb) * DM + 64 * nb; d.ldw = DM; d.gain = nullptr; d.scale = WD_SCALE; d.dst = ws + WS_WD + ((size_t)e * DM + 64 * nb) * DE + 64 * kb; d.ldd = DE; return; } }
    r -= 65 * 256;
    if (r < 1024) { const int kb = r >> 5, nb = r & 31; d.src = INP(I_WOUT) + (size_t)(64 * kb) * DM + 64 * nb; d.ldw = DM; d.gain = (kb < 16) ? INP(I_MOBAG) + 64 * kb : INP(I_NSAG) + 64 * (kb - 16);
        d.scale = 1.0f; d.dst = ws + WS_WOUT + ((size_t)(64 * nb) * DM + 64 * kb) * 2; d.ldd = DM; d.bf = true; return; }
    r -= 1024;
    if (r < 1024) { const int kb = r >> 5, nb = r & 31; d.src = INP(I_WPLEG) + (size_t)(64 * kb) * DM + 64 * nb; d.ldw = DM; d.gain = INP(I_NPLEG) + 64 * kb;
        d.scale = WPG_SCALE; d.dst = ws + WS_WPG + (size_t)(64 * nb) * DM + 64 * kb; d.ldd = DM; return; }
    r -= 1024;
    { const int kb = r >> 5, nb = r & 31; d.src = INP(I_WPLE) + (size_t)(64 * kb) * DM + 64 * nb; d.ldw = DM; d.gain = nullptr;
        d.scale = 1.0f; d.dst = ws + WS_WPLE + ((size_t)(64 * nb) * PLE + 64 * kb) * 2; d.ldd = PLE; d.bf = true; }
}
DI void tr_load(const TrItem& d, f32x4 (&v)[16], float (&g)[16], int lane) {
    const int c4 = (lane & 15) * 4, r0 = lane >> 4;
#pragma unroll
    for (int i = 0; i < 16; ++i) { const int kk = 4 * i + r0; v[i] = *(const f32x4*)(d.src + (size_t)kk * d.ldw + c4); g[i] = d.gain ? d.gain[kk] : 1.0f; }
}
DI void tr_finish_f8(const TrItem& d, const f32x4 (&v)[16], const float (&g)[16], LAS float* scr, int lane) {
    const int c4 = (lane & 15) * 4, r0 = lane >> 4;
#pragma unroll
    for (int i = 0; i < 16; ++i) { const int kk = 4 * i + r0; const f32x4 w = v[i] * (g[i] * d.scale); LAS float* s = scr + kk * 65 + c4; s[0] = w.x; s[1] = w.y; s[2] = w.z; s[3] = w.w; }
    LDS_WAIT();
    const int c = lane & 7, nr = lane >> 3;
#pragma unroll
    for (int j = 0; j < 8; ++j) {
        const int n = nr + 8 * j;
        const LAS float* s = scr + (8 * c) * 65 + n;
        if (d.bf) { u32x4 o; o.x = pk2(s[0 * 65], s[1 * 65]); o.y = pk2(s[2 * 65], s[3 * 65]); o.z = pk2(s[4 * 65], s[5 * 65]); o.w = pk2(s[6 * 65], s[7 * 65]);
            *(u32x4*)(d.dst + ((size_t)n * d.ldd + 8 * c) * 2) = o; }
        else { u32x2 o; o.x = pk4_f8(s[0 * 65], s[1 * 65], s[2 * 65], s[3 * 65]); o.y = pk4_f8(s[4 * 65], s[5 * 65], s[6 * 65], s[7 * 65]);
            *(u32x2*)(d.dst + (size_t)n * d.ldd + 8 * c) = o; }
    }
    LDS_WAIT();
}
DI void conv_expert_items(const PArgs& P, int w0, int nw) {
    static_assert(F8GU == 1 && F8DN == 1, "e4m3 expert weights");
    LAS float* scr = (LAS float*)(P.lds + P.wave * 16640);
    const int lane = P.lane;
    static_assert(F8G3 == 0 && F8PLE == 1, "formats of the late weights");
    constexpr int NIT = 3 * 65 * 256 + 1024 + 1024 + 128;
    if (w0 >= NIT) return;
    TrItem dA, dB; f32x4 vA[16], vB[16]; float gA[16], gB[16];
    tr_expert_desc(P, w0, dA); tr_load(dA, vA, gA, lane);
    for (int it = w0; it < NIT; it += 2 * nw) {
        const bool h1 = it + nw < NIT;
        if (h1) { tr_expert_desc(P, it + nw, dB); tr_load(dB, vB, gB, lane); }
        tr_finish_f8(dA, vA, gA, scr, lane);
        const bool h2 = it + 2 * nw < NIT;
        if (h2) { tr_expert_desc(P, it + 2 * nw, dA); tr_load(dA, vA, gA, lane); }
        if (h1) tr_finish_f8(dB, vB, gB, scr, lane);
    }
    { const f32x4* p = (const f32x4*)INP(I_P); u32x2* pb = (u32x2*)(P.ws + WS_PB);
      const int n4 = NTOK * PLE / 4;
      for (int i = w0 * 64 + lane; i < n4; i += nw * 64) { const f32x4 v = p[i]; u32x2 w; w.x = pk2(v.x, v.y); w.y = pk2(v.z, v.w); pb[i] = w; } }
}

DI void p0_prologue(const PArgs& P) {
    LAS float* scr = (LAS float*)(P.lds + P.wave * 16640);
    const int gw = P.wg * NWAVES + P.wave, NGW = P.G * NWAVES, lane = P.lane;
    unsigned char* ws = P.ws;
    constexpr int I_IN = 32 * 92, I_OUT = 32 * 32, I_PG = 32 * 32, I_PLE_ = 4 * 32, I_R = 32, I_W1 = 4 * 64, I_EG = 65 * 256, I_EU = 65 * 256, I_ED = 65 * 256;
    constexpr int NITEMS = I_IN + I_R + I_W1;
    for (int it = gw; it < NITEMS; it += NGW) {
        int r = it;
        if (r < I_IN) { const int kb = r / 92, nb = r % 92; tr64(INP(I_WIN) + (size_t)(64 * kb) * DIN + 64 * nb, DIN, DIN - 64 * nb, INP(I_NMIXG) + 64 * kb, (bf16_t*)(ws + WS_WIN) + (size_t)(64 * nb) * DM + 64 * kb, DM, scr, lane); continue; } r -= I_IN;
        if (r < I_R) { const int kb = r; tr64(INP(I_WROUTER) + (size_t)(64 * kb) * NE, NE, 64, INP(I_NFFNG) + 64 * kb, (bf16_t*)(ws + WS_WR) + 64 * kb, DM, scr, lane); continue; } r -= I_R;
        if (r < I_W1) { const int kv = r >> 7, q = r & 127, slab = q >> 6, kb = (q >> 1) & 31, nb = q & 1;
            const float* w1 = INP(kv ? I_W1V : I_W1K);
            tr64(w1 + (size_t)(slab * 2048 + 64 * kb) * HD + 64 * nb, HD, 64, nullptr, (bf16_t*)(ws + (kv ? WS_W1V : WS_W1K)) + (size_t)(slab * 128 + 64 * nb) * DM + 64 * kb, DM, scr, lane); continue; } r -= I_W1;
    }
    if (gw < NTOK) {
        const float* x = INP(I_X); bf16_t* xb = (bf16_t*)(ws + WS_HB);
        f32x4 v[8];
        { const f32x4* xr = (const f32x4*)(x + (size_t)gw * DM) + lane;
#pragma unroll
          for (int j = 0; j < 8; ++j) v[j] = xr[64 * j]; }
        for (int row = gw; row < NTOK; row += NGW) {
            const int nrow = (row + NGW < NTOK) ? row + NGW : row;
            f32x4 vn[8];
            { const f32x4* xr = (const f32x4*)(x + (size_t)nrow * DM) + lane;
#pragma unroll
              for (int j = 0; j < 8; ++j) vn[j] = xr[64 * j]; }
            float s = 0.f;
#pragma unroll
            for (int j = 0; j < 8; ++j) s += (v[j].x * v[j].x + v[j].y * v[j].y) + (v[j].z * v[j].z + v[j].w * v[j].w);
            s = wave_sum(s);
            const float rs = 1.0f / sqrtf(s * (1.0f / DM) + EPS);
            u32x2* o = (u32x2*)(xb + (size_t)row * DM) + lane;
#pragma unroll
            for (int j = 0; j < 8; ++j) { u32x2 w; w.x = pk2(v[j].x * rs, v[j].y * rs); w.y = pk2(v[j].z * rs, v[j].w * rs); o[64 * j] = w; }
#pragma unroll
            for (int j = 0; j < 8; ++j) v[j] = vn[j];
        }
    }
    if (gw < 256) {
        const int kv = gw >> 7, n = gw & 127;
        const float* pos = INP(kv ? I_POSV : I_POSK); const float* w1 = INP(kv ? I_W1V : I_W1K);
        float s = 0.f;
        for (int k = lane; k < 4096; k += 64) s += pos[k] * w1[(size_t)k * HD + n];
        s = wave_sum(s);
        if (lane == 0) ((float*)(ws + WS_BIAS))[gw] = s;
    }
}

namespace pg8 {
constexpr int BM = 256, BK = 64, HALF = 128, HTB = HALF * BK * 2, STAGE_BYTES = 8 * HTB;
DI int lds_byte(int r, int c) { const int st = (r >> 4) * 2 + (c >> 5), rr = r & 15, cc = c & 31, ob = rr * 64 + cc * 2; return st * 1024 + (ob ^ (((ob >> 9) & 1) << 5)); }
DI void stage_rc(int b, int& R, int& C) { const int st = b / 1024, sb = b % 1024, swz = sb ^ (((sb >> 9) & 1) << 5); R = (st >> 1) * 16 + swz / 64; C = (st & 1) * 32 + (swz % 64) / 2; }
DI int perm32(int rho) { const int n = rho >> 4, i = rho & 15; return 8 * (i >> 2) + 4 * n + (i & 3); }

struct Unit { const char* B; int arow0; const int* tok; int nvalid; int pm, pn, e; };

template <class Epi, class Sched, bool FP8 = false, bool CM64 = false, int PROBE = 0>
DI void gemm_phase(LAS unsigned char* lds, int wid, const bf16_t* Abase, int K, const Sched& S, const Epi& E) {
    const int lane = lane_id_v(), tid = wid * 64 + lane, wr = wid >> 2, wc = wid & 3, fr = lane & 15, fq = lane >> 4;
    asm volatile("" : "+s"(K));
    const int nt = K / BK;
    unsigned voffB[2];
#pragma unroll
    for (int i = 0; i < 2; ++i) { int R, C; stage_rc(tid * 16 + i * 8192, R, C); const int Rb = (CM64 ? (R >> 5) * 64 : (R & ~31)) + perm32(R & 31); voffB[i] = (unsigned)(Rb * K + C) * 2u; }
    const size_t kstep = (size_t)(BK * 2);
    const size_t hstepB = (size_t)(CM64 ? 32 : HALF) * K * 2;
    const unsigned ldsw = (unsigned)wid * 1024u;
    const int aoff = FP8 ? lds_byte(wr * 64 + fr, (fq & 1) * 16) + (fq >> 1) * 1024 : lds_byte(wr * 64 + fr, fq * 8);
    const int boff = FP8 ? lds_byte(wc * 32 + fr, (fq & 1) * 16) + (fq >> 1) * 1024 : lds_byte(wc * 32 + fr, fq * 8);
#define PG8_SA(b, h) (((b) * 2 + (h)) * HTB)
#define PG8_SB(b, h) ((4 + (b) * 2 + (h)) * HTB)
#define PG8_STAGEB(bufoff, gbase) do { unsigned _b0 = voffB[0], _b1 = voffB[1]; const char* _bk = (const char*)(gbase); unsigned _lw = ldsw; asm volatile("" : "+v"(_b0), "+v"(_b1), "+s"(_bk), "+s"(_lw));     \
        __builtin_amdgcn_global_load_lds((const unsigned*)(_bk + _b0), (LAS unsigned*)(lds + (bufoff) + _lw), 16, 0, 0); \
        __builtin_amdgcn_global_load_lds((const unsigned*)(_bk + _b1), (LAS unsigned*)(lds + (bufoff) + _lw + 8192), 16, 0, 0); } while (0)
#define PG8_STAGEA(bufoff, kb, o0, o1) do { const char* _ak = (const char*)Abase + (kb); unsigned _o0 = (o0), _o1 = (o1), _lw = ldsw; \
        asm volatile("" : "+v"(_o0), "+v"(_o1), "+s"(_ak), "+s"(_lw));     \
        __builtin_amdgcn_global_load_lds((const unsigned*)(_ak + _o0), (LAS unsigned*)(lds + (bufoff) + _lw), 16, 0, 0); \
        __builtin_amdgcn_global_load_lds((const unsigned*)(_ak + _o1), (LAS unsigned*)(lds + (bufoff) + _lw + 8192), 16, 0, 0); } while (0)
#define PG8_RD16(off) (*(const LAS u32x4*)(lds + (off)))
#define PG8_LDA(dst, b, h) do { if (PROBE == 2) break; _Pragma("unroll") for (int m = 0; m < 4; ++m) { \
        if constexpr (FP8) { const u32x4 _p = *(const LAS u32x4*)(abase8 + (PG8_SA(b, h) + m * 2048)), _q = *(const LAS u32x4*)(abase8 + (PG8_SA(b, h) + m * 2048 + 16)); \
            dst##8[m] = (v8i32){(int)_p.x, (int)_p.y, (int)_p.z, (int)_p.w, (int)_q.x, (int)_q.y, (int)_q.z, (int)_q.w}; } \
        else { _Pragma("unroll") for (int k = 0; k < 2; ++k) dst[m][k] = *(const LAS bf16x8*)(lds + PG8_SA(b, h) + aoff + m * 2048 + k * 1024); } } } while (0)
#define PG8_LDB(dst, b, h) do { if (PROBE == 1) break; _Pragma("unroll") for (int n = 0; n < 2; ++n) { \
        if constexpr (FP8) { const u32x4 _p = *(const LAS u32x4*)(bbase8 + (PG8_SB(b, h) - 65536 + n * 2048)), _q = *(const LAS u32x4*)(bbase8 + (PG8_SB(b, h) - 65536 + n * 2048 + 16)); \
            dst##8[n] = (v8i32){(int)_p.x, (int)_p.y, (int)_p.z, (int)_p.w, (int)_q.x, (int)_q.y, (int)_q.z, (int)_q.w}; } \
        else { _Pragma("unroll") for (int k = 0; k < 2; ++k) dst[n][k] = *(const LAS bf16x8*)(lds + PG8_SB(b, h) + boff + n * 2048 + k * 1024); } } } while (0)
#define PG8_MMA(ai, bj, At, Bt) do { if (PROBE == 3) break; \
        if constexpr (FP8) { _Pragma("unroll") for (int m = 0; m < 4; ++m) _Pragma("unroll") for (int n = 0; n < 2; ++n) \
            acc[ai][bj][m][n] = __builtin_amdgcn_mfma_scale_f32_16x16x128_f8f6f4(Bt##8[n], At##8[m], acc[ai][bj][m][n], 0, 0, 0, 127, 0, 127);     } \
        else { _Pragma("unroll") for (int m = 0; m < 4; ++m) _Pragma("unroll") for (int n = 0; n < 2; ++n) _Pragma("unroll") for (int k = 0; k < 2; ++k) \
            acc[ai][bj][m][n] = __builtin_amdgcn_mfma_f32_16x16x32_bf16(Bt[n][k], At[m][k], acc[ai][bj][m][n], 0, 0, 0); } \
        } while (0)
#define PG8_WAIT_V(n) asm volatile("s_waitcnt vmcnt(" #n ")" ::: "memory")
#define PG8_WAIT_L(n) asm volatile("s_waitcnt lgkmcnt(" #n ")" ::: "memory")
#define PG8_BAR __builtin_amdgcn_s_barrier()
#define PG8_SCHED __builtin_amdgcn_sched_barrier(0)
#define PG8_AOFFS(u, dst) do { const int _tq = wid * 64 + lane_id_v();   \
        _Pragma("unroll") for (int _i = 0; _i < 2; ++_i) { int _R, _C; stage_rc(_tq * 16 + _i * 8192, _R, _C); \
        _Pragma("unroll") for (int _h = 0; _h < 2; ++_h) { \
        const int _r = _h * HALF + _R; int _row; \
        if ((u).tok) { const int _rc = _r < (u).nvalid ? _r : (u).nvalid - 1; _row = (u).tok[_rc]; } else _row = (u).arow0 + _r; \
        dst[_h][_i] = (unsigned)_row * (unsigned)(K * 2) + (unsigned)(_C * 2); } } } while (0)
    unsigned ab8_ = (unsigned)(uintptr_t)(lds + aoff), bb8_ = (unsigned)(uintptr_t)(lds + boff) + 65536u;
    asm volatile("" : "+v"(ab8_), "+v"(bb8_));
    const LAS unsigned char* abase8 = (const LAS unsigned char*)(uintptr_t)ab8_; const LAS unsigned char* bbase8 = (const LAS unsigned char*)(uintptr_t)bb8_;
    Unit cur, nxt; int ui = 0;
    if (!S.next(0, cur)) return;
    f32x4 acc[2][2][4][2];
#pragma unroll
    for (int a = 0; a < 2; ++a)
#pragma unroll
        for (int b = 0; b < 2; ++b)
#pragma unroll
            for (int m = 0; m < 4; ++m)
#pragma unroll
                for (int n = 0; n < 2; ++n) acc[a][b][m][n] = (f32x4){0.f, 0.f, 0.f, 0.f};
    bf16x8 At[4][2] = {}, B0[2][2] = {}, B1[2][2] = {};
    v8i32 At8[4] = {}, B08[2] = {}, B18[2] = {};
    unsigned ao[2][2], an[2][2];
    PG8_AOFFS(cur, ao);
    const char* cB = cur.B;
    PG8_STAGEB(PG8_SB(0, 0), cB); PG8_STAGEB(PG8_SB(0, 1), cB + hstepB); PG8_STAGEA(PG8_SA(0, 0), 0, ao[0][0], ao[0][1]); PG8_STAGEA(PG8_SA(0, 1), 0, ao[1][0], ao[1][1]);
    if (wr == 1) PG8_BAR;
    PG8_WAIT_V(2); PG8_BAR;
    PG8_STAGEB(PG8_SB(1, 0), cB + kstep); PG8_STAGEA(PG8_SA(1, 0), kstep, ao[0][0], ao[0][1]); PG8_STAGEB(PG8_SB(1, 1), cB + hstepB + kstep);
    PG8_WAIT_V(6); PG8_BAR;
    for (;;) {
        const bool has_next = S.next(ui + 1, nxt);
        const char* nB = has_next ? nxt.B : cB;
        if (Sched::GATHER) {
            if (has_next) { PG8_AOFFS(nxt, an); } else {
#pragma unroll
                for (int h = 0; h < 2; ++h)
#pragma unroll
                    for (int i = 0; i < 2; ++i) an[h][i] = ao[h][i]; } }
        for (int t = 0; t < nt; t += 2) {
            const bool last = (t == nt - 2);
            if (!Sched::GATHER) {
                const Unit& un_ = (last && has_next) ? nxt : cur; PG8_AOFFS(un_, an); }
            const size_t k1 = (size_t)(t + 1) * kstep;
            const size_t k2 = last ? 0 : (size_t)(t + 2) * kstep, k3 = k2 + kstep;
            const char* b2 = last ? nB : cB + (size_t)(t + 2) * kstep; const char* b3 = b2 + kstep;
            const unsigned a200 = last ? an[0][0] : ao[0][0], a201 = last ? an[0][1] : ao[0][1], a210 = last ? an[1][0] : ao[1][0], a211 = last ? an[1][1] : ao[1][1];
            PG8_LDB(B0, 0, 0); PG8_LDB(B1, 0, 1); PG8_SCHED; PG8_LDA(At, 0, 0); PG8_STAGEA(PG8_SA(1, 1), k1, ao[1][0], ao[1][1]);
            PG8_WAIT_V(8); PG8_WAIT_L(0); PG8_BAR; __builtin_amdgcn_s_setprio(1); PG8_MMA(0, 0, At, B0); PG8_MMA(0, 1, At, B1); __builtin_amdgcn_s_setprio(0); PG8_BAR; PG8_SCHED;
            PG8_LDA(At, 0, 1); PG8_STAGEB(PG8_SB(0, 0), b2); PG8_STAGEB(PG8_SB(0, 1), b2 + hstepB); PG8_STAGEA(PG8_SA(0, 0), k2, a200, a201);
            PG8_WAIT_V(8); PG8_WAIT_L(0); PG8_BAR; __builtin_amdgcn_s_setprio(1); PG8_MMA(1, 0, At, B0); PG8_MMA(1, 1, At, B1); __builtin_amdgcn_s_setprio(0); PG8_BAR; PG8_SCHED;
            PG8_LDB(B0, 1, 0); PG8_LDB(B1, 1, 1); PG8_SCHED; PG8_LDA(At, 1, 0); PG8_STAGEA(PG8_SA(0, 1), k2, a210, a211);
            PG8_WAIT_V(8); PG8_WAIT_L(0); PG8_BAR; __builtin_amdgcn_s_setprio(1); PG8_MMA(0, 0, At, B0); PG8_MMA(0, 1, At, B1); __builtin_amdgcn_s_setprio(0); PG8_BAR; PG8_SCHED;
            PG8_LDA(At, 1, 1); PG8_STAGEB(PG8_SB(1, 0), b3); PG8_STAGEB(PG8_SB(1, 1), b3 + hstepB); PG8_STAGEA(PG8_SA(1, 0), k3, a200, a201);
            PG8_WAIT_V(8); PG8_WAIT_L(0); PG8_BAR; __builtin_amdgcn_s_setprio(1); PG8_MMA(1, 0, At, B0); PG8_MMA(1, 1, At, B1); __builtin_amdgcn_s_setprio(0); PG8_BAR; PG8_SCHED;
        }
        if (wr == 0) PG8_BAR;
        { const int lz_ = lane_id_v();
          E(acc, cur, wr, wc, lz_ & 15, lz_ >> 4); }
        if (!has_next) break;
#pragma unroll
        for (int a = 0; a < 2; ++a)
#pragma unroll
            for (int b = 0; b < 2; ++b)
#pragma unroll
                for (int m = 0; m < 4; ++m)
#pragma unroll
                    for (int n = 0; n < 2; ++n) acc[a][b][m][n] = (f32x4){0.f, 0.f, 0.f, 0.f};
        cur = nxt; cB = nB; ++ui;
#pragma unroll
        for (int h = 0; h < 2; ++h)
#pragma unroll
            for (int i = 0; i < 2; ++i) ao[h][i] = an[h][i];
        if (wr == 1) PG8_BAR;
    }
    PG8_WAIT_V(0);
    PG8_BAR;
#undef PG8_SA
#undef PG8_SB
#undef PG8_STAGEA
#undef PG8_STAGEB
#undef PG8_LDA
#undef PG8_LDB
#undef PG8_MMA
#undef PG8_RD16
#undef PG8_WAIT_V
#undef PG8_WAIT_L
#undef PG8_BAR
#undef PG8_SCHED
#undef PG8_AOFFS
}

struct GridOrder {
    static constexpr bool GATHER = false;
    int nM, nN, nwg, G, c; const char* Bt; size_t bstep;
    DI void init(int nM_, int nN_, int G_, int c_, const void* Bt_, int K) { nM = nM_; nN = nN_; nwg = nM * nN; G = G_; c = c_; Bt = (const char*)Bt_; bstep = (size_t)256 * K * 2; }
    DI bool next(int i, Unit& u) const {
        const int L = i * G + c; if (L >= nwg) return false;
        int wgid = L; { const int q = nwg / 8, r = nwg % 8, xcd = wgid % 8, off = wgid / 8; wgid = (xcd < r ? xcd * (q + 1) : r * (q + 1) + (xcd - r) * q) + off; }
        const int nig = 8 * nN, gid = wgid / nig, fm = gid * 8, gsz = (nM - fm) < 8 ? (nM - fm) : 8;
        u.pm = fm + ((wgid % nig) % gsz); u.pn = (wgid % nig) / gsz;
        u.B = Bt + (size_t)u.pn * bstep; u.arow0 = u.pm * 256; u.tok = nullptr; u.nvalid = 256; u.e = 0; return true;
    }
};
struct RowOrder {
    static constexpr bool GATHER = false;
    int nwg, G, c; const char* Bt; size_t bstep;
    DI bool next(int i, Unit& u) const {
        const int L = i * G + c; if (L >= nwg) return false;
        u.pm = L >> 3; u.pn = L & 7; u.B = Bt + (size_t)u.pn * bstep; u.arow0 = u.pm * 256; u.tok = nullptr; u.nvalid = 256; u.e = 0; return true;
    }
};
}
namespace pg8 {
#define EPI_ROWS(ai, m) ((ai) * HALF + wr * 64 + (m) * 16 + fr)
#define EPI_COL(bj) ((bj) * HALF + wc * 32 + 8 * fq)
DI u32x2 pack8_f8(const f32x4 v0, const f32x4 v1) {
    unsigned a = 0u, b = 0u;
    a = __builtin_amdgcn_cvt_pk_fp8_f32(v0[0], v0[1], a, false); a = __builtin_amdgcn_cvt_pk_fp8_f32(v0[2], v0[3], a, true);
    b = __builtin_amdgcn_cvt_pk_fp8_f32(v1[0], v1[1], b, false); b = __builtin_amdgcn_cvt_pk_fp8_f32(v1[2], v1[3], b, true);
    u32x2 w; w.x = a; w.y = b; return w;
}
DI unsigned xor8(unsigned v) { return (unsigned)__builtin_amdgcn_update_dpp(0, (int)v, 0x128, 0xF, 0xF, false); }
DI u32x4 xor8(const u32x4 v) { u32x4 r; r.x = xor8(v.x); r.y = xor8(v.y); r.z = xor8(v.z); r.w = xor8(v.w); return r; }
#define EPI_CM64_SWAP(p0, p1, d1, d2) do { const bool hi_ = fr >= 8; const u32x4 snd_ = hi_ ? (p0) : (p1); const u32x4 rcv_ = xor8(snd_); d1 = hi_ ? rcv_ : (p0); d2 = hi_ ? (p1) : rcv_; } while (0)
#define EPI_CM64_ROW(ai, m) ((ai) * HALF + wr * 64 + (m) * 16 + (fr & 7))
#define EPI_CM64_COL (wc * 64 + (fr >> 3) * 32 + 8 * fq)
DI u32x4 pack8(const f32x4 v0, const f32x4 v1) { u32x4 w; w.x = pk2(v0[0], v0[1]); w.y = pk2(v0[2], v0[3]); w.z = pk2(v1[0], v1[1]); w.w = pk2(v1[2], v1[3]); return w; }

struct EpiProj {
    static constexpr bool HAS_ROWSC = true;
    unsigned char* ws; const float* rs0;
    DI float row_scalar(const Unit& u, int r) const { return rs0[u.pm * BM + r]; }
    DI void operator()(const f32x4 (&acc)[2][2][4][2], const Unit& u, int wr, int wc, int fr, int fq) const {
        const int pn = u.pn, c = EPI_CM64_COL;
        const int tsr = pn >> 2; const float qs = (pn < 16 && (tsr == 0 || tsr == 3)) ? QSCALE : 1.0f;
#pragma unroll
        for (int ai = 0; ai < 2; ++ai)
#pragma unroll
            for (int m = 0; m < 4; ++m) {
                const int row = u.pm * BM + EPI_CM64_ROW(ai, m);
                const u32x4 p0 = pack8(acc[ai][0][m][0] * qs, acc[ai][0][m][1] * qs), p1 = pack8(acc[ai][1][m][0] * qs, acc[ai][1][m][1] * qs);
                u32x4 d1, d2; EPI_CM64_SWAP(p0, p1, d1, d2);
                if (pn < 16) {
                    bf16_t* dst = (bf16_t*)(ws + WS_MQ + (size_t)tsr * 64 * MiB) + (size_t)row * 1024 + (pn & 3) * 256 + c;
                    *(u32x4*)dst = d1; *(u32x4*)(dst + 8 * 1024) = d2;
                } else if (pn < 22) {
                    const int b = row >> 13, t = row & 8191, g = c >> 7, d = c & 127;
                    bf16_t* dst = (bf16_t*)(ws + WS_KC + (size_t)(pn - 16) * 16 * MiB) + ((size_t)(b * 2 + g) * NT + t) * HD + d;
                    *(u32x4*)dst = d1; *(u32x4*)(dst + 8 * HD) = d2;
                }
            }
    }
};
struct EpiNull {
    static constexpr bool HAS_ROWSC = false;
    DI float row_scalar(const Unit&, int) const { return 0.f; }
    DI void operator()(const f32x4 (&acc)[2][2][4][2], const Unit& u, int wr, int wc, int fr, int fq) const {
#pragma unroll
        for (int ai = 0; ai < 2; ++ai)
#pragma unroll
            for (int bj = 0; bj < 2; ++bj)
#pragma unroll
                for (int m = 0; m < 4; ++m)
#pragma unroll
                    for (int n = 0; n < 2; ++n) asm volatile("" :: "v"(acc[ai][bj][m][n]));
    }
};
struct EpiF32 {
    static constexpr bool HAS_ROWSC = false;
    DI float row_scalar(const Unit&, int) const { return 0.f; }
    float* C; int ldc;
    DI void operator()(const f32x4 (&acc)[2][2][4][2], const Unit& u, int wr, int wc, int fr, int fq) const {
        float* Cb = C + (size_t)u.e * 4096 * 256;
#pragma unroll
        for (int ai = 0; ai < 2; ++ai)
#pragma unroll
            for (int m = 0; m < 4; ++m) { float* rp = Cb + (size_t)(u.pm * BM + EPI_ROWS(ai, m)) * ldc + u.pn * BM;
#pragma unroll
                for (int bj = 0; bj < 2; ++bj) { const int c = EPI_COL(bj); *(f32x4*)(rp + c) = acc[ai][bj][m][0]; *(f32x4*)(rp + c + 4) = acc[ai][bj][m][1]; } }
    }
};
struct EpiBf16 {
    static constexpr bool HAS_ROWSC = false;
    DI float row_scalar(const Unit&, int) const { return 0.f; }
    bf16_t* O; int ldc;
    DI void operator()(const f32x4 (&acc)[2][2][4][2], const Unit& u, int wr, int wc, int fr, int fq) const {
#pragma unroll
        for (int ai = 0; ai < 2; ++ai)
#pragma unroll
            for (int m = 0; m < 4; ++m) { bf16_t* rp = O + (size_t)(u.pm * BM + EPI_ROWS(ai, m)) * ldc + u.pn * BM;
#pragma unroll
                for (int bj = 0; bj < 2; ++bj) *(u32x4*)(rp + EPI_COL(bj)) = pack8(acc[ai][bj][m][0], acc[ai][bj][m][1]); }
    }
};
struct EpiOut {
    static constexpr bool HAS_ROWSC = false;
    DI float row_scalar(const Unit&, int) const { return 0.f; }
    const float* x; bf16_t* xb; float* ssq; unsigned char* x8;
    DI void operator()(const f32x4 (&acc)[2][2][4][2], const Unit& u, int wr, int wc, int fr, int fq) const {
        f32x4 xa[2][2], xn[2][2]; float ssv[8];
#pragma unroll
        for (int bj = 0; bj < 2; ++bj) { const size_t o = (size_t)(u.pm * BM + EPI_ROWS(0, 0)) * DM + u.pn * BM + EPI_COL(bj); xa[bj][0] = *(const f32x4*)(x + o); xa[bj][1] = *(const f32x4*)(x + o + 4); }
#pragma unroll
        for (int i = 0; i < 8; ++i) {
            const int ai = i >> 2, m = i & 3;
            if (i + 1 < 8) {
#pragma unroll
                for (int bj = 0; bj < 2; ++bj) { const size_t o = (size_t)(u.pm * BM + EPI_ROWS((i + 1) >> 2, (i + 1) & 3)) * DM + u.pn * BM + EPI_COL(bj); xn[bj][0] = *(const f32x4*)(x + o); xn[bj][1] = *(const f32x4*)(x + o + 4); }
            }
            const int row = u.pm * BM + EPI_ROWS(ai, m); float ss = 0.f;
#pragma unroll
            for (int bj = 0; bj < 2; ++bj) { const size_t o = (size_t)row * DM + u.pn * BM + EPI_COL(bj);
                const f32x4 v0 = xa[bj][0] + acc[ai][bj][m][0] * (1.0f / WOUT_SCALE), v1 = xa[bj][1] + acc[ai][bj][m][1] * (1.0f / WOUT_SCALE);
                *(u32x4*)(xb + o) = pack8(v0, v1); if (F8GU) *(u32x2*)(x8 + o) = pack8_f8(v0, v1);
                ss += (v0[0] * v0[0] + v0[1] * v0[1]) + (v0[2] * v0[2] + v0[3] * v0[3]) + (v1[0] * v1[0] + v1[1] * v1[1]) + (v1[2] * v1[2] + v1[3] * v1[3]); }
            ss += __shfl_xor(ss, 16); ss += __shfl_xor(ss, 32);
            ssv[i] = ss;
#pragma unroll
            for (int bj = 0; bj < 2; ++bj) { xa[bj][0] = xn[bj][0]; xa[bj][1] = xn[bj][1]; }
        }
        if (fq == 0) {
#pragma unroll
            for (int i = 0; i < 8; ++i) atomicAdd(ssq + u.pm * BM + EPI_ROWS(i >> 2, i & 3), ssv[i]);
        }
    }
};
struct EpiGU {
    static constexpr bool HAS_ROWSC = false;
    unsigned char* H; const float* rsl; const float* rs1; const LAS int* pstart;
    DI float row_scalar(const Unit& u, int r) const { if (u.e < 64) { const int rc = r < u.nvalid ? r : u.nvalid - 1; return rsl[(size_t)u.e * 32768 + u.pm * 256 + rc]; } return rs1[u.pm * 256 + r]; }
    DI void operator()(const f32x4 (&acc)[2][2][4][2], const Unit& u, int wr, int wc, int fr, int fq) const {
        const int e = u.e, mt = u.pm, nt_ = u.pn;
        const unsigned rowbase = (unsigned)__builtin_amdgcn_readfirstlane(pstart[e]) + (unsigned)mt * 256u;
        const char* rb_ = (e < 64) ? (const char*)rsl + (unsigned)((e * 32768 + mt * 256) * 4) : (const char*)rs1 + (unsigned)(mt * 256 * 4);
        const int nv_ = (e < 64) ? u.nvalid : 256;
#define EPIGU_RS(i) (*(const float*)(rb_ + (unsigned)(((EPI_ROWS((i) >> 2, (i) & 3)) < nv_ ? (EPI_ROWS((i) >> 2, (i) & 3)) : nv_ - 1) * 4)))
        float rs_n = EPIGU_RS(0);
#pragma unroll
        for (int ai = 0; ai < 2; ++ai)
#pragma unroll
            for (int m = 0; m < 4; ++m) {
                const int r = EPI_ROWS(ai, m);
                float rs = rs_n;
                if (ai * 4 + m + 1 < 8) rs_n = EPIGU_RS(ai * 4 + m + 1);
                rs *= (1.0f / WGU_SCALE);
                f32x4 g0 = acc[ai][0][m][0] * rs, g1 = acc[ai][0][m][1] * rs, u0 = acc[ai][1][m][0] * rs, u1 = acc[ai][1][m][1] * rs, h0, h1;
#pragma unroll
                for (int j = 0; j < 4; ++j) { h0[j] = g0[j] * __builtin_amdgcn_rcpf(1.0f + __expf(-g0[j])) * u0[j]; h1[j] = g1[j] * __builtin_amdgcn_rcpf(1.0f + __expf(-g1[j])) * u1[j]; }
                const unsigned hoff = (rowbase + (unsigned)r) * (unsigned)DE + (unsigned)(nt_ * 128 + wc * 32 + 8 * fq);
                if (F8DN) *(u32x2*)(H + hoff) = pack8_f8(h0, h1); else *(u32x4*)(H + 2u * hoff) = pack8(h0, h1);
            }
    }
};
struct EpiDown {
    static constexpr bool HAS_ROWSC = true;
    unsigned char* Yp; bf16_t* xres; const LAS int* pstart;
    DI void operator()(const f32x4 (&acc)[2][2][4][2], const Unit& u, int wr, int wc, int fr, int fq) const {
        const int e = u.e, mt = u.pm;
        if (e < 64) {
            const unsigned rowbase = (unsigned)__builtin_amdgcn_readfirstlane(pstart[e]) + (unsigned)mt * 256u;
#pragma unroll
            for (int ai = 0; ai < 2; ++ai)
#pragma unroll
                for (int m = 0; m < 4; ++m) {
                    const int r = EPI_ROWS(ai, m);
                    { const u32x2 y0 = pack8_f8(acc[ai][0][m][0] * (YP_SCALE / WD_SCALE), acc[ai][0][m][1] * (YP_SCALE / WD_SCALE)), y1 = pack8_f8(acc[ai][1][m][0] * (YP_SCALE / WD_SCALE), acc[ai][1][m][1] * (YP_SCALE / WD_SCALE));
                      u32x4 y; y.x = y0.x; y.y = y0.y; y.z = y1.x; y.w = y1.y;
                      *(u32x4*)((char*)Yp + (unsigned)((((rowbase >> 8) * 8u + (unsigned)u.pn) * 256u + (unsigned)r) * 256u + (unsigned)(wc * 64 + fq * 16))) = y; }
                }
        } else if (xres) {
#pragma unroll
            for (int ai = 0; ai < 2; ++ai) {
                u32x4 old[4][2];
#pragma unroll
                for (int m = 0; m < 4; ++m)
#pragma unroll
                    for (int bj = 0; bj < 2; ++bj) old[m][bj] = *(const u32x4*)((const char*)xres + (unsigned)(((unsigned)(mt * 256 + EPI_ROWS(ai, m)) * (unsigned)DM + (unsigned)(u.pn * 256 + EPI_COL(bj))) * 2u));
#pragma unroll
                for (int m = 0; m < 4; ++m)
#pragma unroll
                    for (int bj = 0; bj < 2; ++bj) { u32x4* o = (u32x4*)((char*)xres + (unsigned)(((unsigned)(mt * 256 + EPI_ROWS(ai, m)) * (unsigned)DM + (unsigned)(u.pn * 256 + EPI_COL(bj))) * 2u)); const u32x4 od = old[m][bj];
                        f32x4 v0 = acc[ai][bj][m][0] * (1.0f / WD_SCALE), v1 = acc[ai][bj][m][1] * (1.0f / WD_SCALE);
                        v0[0] += bflo(od.x); v0[1] += bfhi(od.x); v0[2] += bflo(od.y); v0[3] += bfhi(od.y); v1[0] += bflo(od.z); v1[1] += bfhi(od.z); v1[2] += bflo(od.w); v1[3] += bfhi(od.w);
                        *o = pack8(v0, v1); }
            }
        }
    }
};
struct EpiPleFin {
    static constexpr bool HAS_ROWSC = true;
    const bf16_t* xres; float* out; const bf16_t* PP; const float* rs2; float* ssq; unsigned* arrive; const float* gfin;
    DI float row_scalar(const Unit& u, int r) const { return rs2[u.pm * BM + r]; }
    DI void operator()(f32x4 (&acc)[2][2][4][2], const Unit& u, int wr, int wc, int fr, int fq) const {
        float ssv[8];
#pragma unroll
        for (int ai = 0; ai < 2; ++ai)
#pragma unroll
            for (int m = 0; m < 4; ++m) {
                const int row = u.pm * BM + EPI_ROWS(ai, m); const float rs = rs2[row] * (1.0f / WPG_SCALE); float ss = 0.f;
#pragma unroll
                for (int bj = 0; bj < 2; ++bj) { const size_t o = (size_t)row * DM + u.pn * BM + EPI_COL(bj);
                    const u32x4 pp = *(const u32x4*)(PP + o), xr = *(const u32x4*)(xres + o);
                    const f32x4 p0 = {bflo(pp.x), bfhi(pp.x), bflo(pp.y), bfhi(pp.y)}, p1 = {bflo(pp.z), bfhi(pp.z), bflo(pp.w), bfhi(pp.w)};
                    f32x4 v0 = {bflo(xr.x), bfhi(xr.x), bflo(xr.y), bfhi(xr.y)}, v1 = {bflo(xr.z), bfhi(xr.z), bflo(xr.w), bfhi(xr.w)};
#pragma unroll
                    for (int j = 0; j < 4; ++j) { v0[j] += p0[j] * __builtin_amdgcn_rcpf(1.0f + __expf(-rs * acc[ai][bj][m][0][j])); v1[j] += p1[j] * __builtin_amdgcn_rcpf(1.0f + __expf(-rs * acc[ai][bj][m][1][j])); }
                    acc[ai][bj][m][0] = v0; acc[ai][bj][m][1] = v1;
                    ss += (v0[0] * v0[0] + v0[1] * v0[1]) + (v0[2] * v0[2] + v0[3] * v0[3]) + (v1[0] * v1[0] + v1[1] * v1[1]) + (v1[2] * v1[2] + v1[3] * v1[3]); }
                ss += __shfl_xor(ss, 16); ss += __shfl_xor(ss, 32);
                ssv[ai * 4 + m] = ss;
            }
        if (fq == 0) {
#pragma unroll
            for (int i = 0; i < 8; ++i) atomicAdd(ssq + u.pm * BM + EPI_ROWS(i >> 2, i & 3), ssv[i]);
        }
        asm volatile("s_waitcnt vmcnt(0)" ::: "memory");
        __syncthreads();
        if (wr == 0 && wc == 0 && fr == 0 && fq == 0) {
            unsigned* a = arrive + (size_t)u.pm * 32;
            (void)__hip_atomic_fetch_add(a, 1u, __ATOMIC_RELAXED, __HIP_MEMORY_SCOPE_AGENT);
            while (__hip_atomic_load(a, __ATOMIC_RELAXED, __HIP_MEMORY_SCOPE_AGENT) < 8u) __builtin_amdgcn_s_sleep(2);
        }
        __syncthreads();
        f32x4 g[2][2];
#pragma unroll
        for (int bj = 0; bj < 2; ++bj) { const float* gp = gfin + u.pn * BM + EPI_COL(bj); g[bj][0] = *(const f32x4*)gp; g[bj][1] = *(const f32x4*)(gp + 4); }
        float svv[8];
#pragma unroll
        for (int i = 0; i < 8; ++i) svv[i] = __hip_atomic_load(ssq + u.pm * BM + EPI_ROWS(i >> 2, i & 3), __ATOMIC_RELAXED, __HIP_MEMORY_SCOPE_AGENT);
#pragma unroll
        for (int ai = 0; ai < 2; ++ai)
#pragma unroll
            for (int m = 0; m < 4; ++m) {
                const int row = u.pm * BM + EPI_ROWS(ai, m);
                const float rs3 = __builtin_amdgcn_rsqf(svv[ai * 4 + m] * (1.0f / DM) + EPS);
#pragma unroll
                for (int bj = 0; bj < 2; ++bj) { float* op = out + (size_t)row * DM + u.pn * BM + EPI_COL(bj);
                    *(f32x4*)op = acc[ai][bj][m][0] * rs3 * g[bj][0]; *(f32x4*)(op + 4) = acc[ai][bj][m][1] * rs3 * g[bj][1]; }
            }
    }
};
#undef EPIGU_RS
#undef EPI_ROWS
#undef EPI_COL
#undef EPI_CM64_SWAP
#undef EPI_CM64_ROW
#undef EPI_CM64_COL

struct CmpOrder {
    static constexpr bool GATHER = false;
    int G, c; const char* W1K; const char* W1V;
    DI bool next(int i, Unit& u) const {
        const int L = i * G + c; if (L >= 32) return false;
        u.e = L >> 4; u.pm = L & 15; u.pn = 0; u.arow0 = L * 256;
        u.B = u.e ? W1V : W1K; u.tok = nullptr; u.nvalid = 256; return true;
    }
};
template <bool GATHER_, int NTLOG = 2> struct MoeOrder {
    static constexpr bool GATHER = GATHER_;
    int G, c; const LAS int* mtoff; const LAS int* cnt; int total;
    const char* Wbase; size_t estep, nstep; int pn0;
    const int* tokl; bool gather; const LAS int* pstart;
    DI bool next(int i, Unit& u) const {
        const int L = i * G + c; if (L >= total) return false;
        const int g = L >> NTLOG, nt_ = L & ((1 << NTLOG) - 1);
        int lo = 0, hi = 65;
        while (hi - lo > 1) { const int mid = (lo + hi) >> 1; if (mtoff[mid] <= g) lo = mid; else hi = mid; }
        const int e = __builtin_amdgcn_readfirstlane(lo), mt = __builtin_amdgcn_readfirstlane(g - mtoff[lo]);
        u.e = e; u.pm = mt; u.pn = pn0 + nt_;
        u.B = Wbase + (size_t)e * estep + (size_t)(pn0 + nt_) * nstep;
        const int ce = __builtin_amdgcn_readfirstlane(cnt[e]); u.nvalid = (ce - mt * 256) < 256 ? (ce - mt * 256) : 256;
        if (gather) { u.tok = (e < 64) ? tokl + (size_t)e * 32768 + mt * 256 : nullptr; u.arow0 = mt * 256; }
        else { u.tok = nullptr; u.arow0 = __builtin_amdgcn_readfirstlane(pstart[e]) + mt * 256; }
        return true;
    }
};
}
namespace att {
constexpr int VP = 320;
constexpr int KT_BYTES = 64 * 256, VT_BYTES = 64 * VP, BUF_BYTES = KT_BYTES + VT_BYTES;
constexpr int SCR_OFF = 2 * BUF_BYTES;
constexpr float THR = 8.0f, MASKV = -3.0e38f, MINIT = -1.0e30f;
#define KSWZ(row, colB) ((row) * 256 + ((colB) ^ (((row) & 7) << 4)))
#define CRC(r) (((r) & 3) + 8 * ((r) >> 2))
#define MFMA32(a, b, c) __builtin_amdgcn_mfma_f32_32x32x16_bf16((a), (b), (c), 0, 0, 0)

struct Stage { u32x4 k0, k1, v0, v1; };
DI void stage_load(Stage& s, const bf16_t* Kt, const bf16_t* Vt, int ld, int sr, int sc) {
    s.k0 = *(const u32x4*)(Kt + (size_t)sr * ld + sc); s.k1 = *(const u32x4*)(Kt + (size_t)(32 + sr) * ld + sc);
    s.v0 = *(const u32x4*)(Vt + (size_t)sr * ld + sc); s.v1 = *(const u32x4*)(Vt + (size_t)(32 + sr) * ld + sc);
}
DI void stage_write(const Stage& s, LAS unsigned char* buf, int sr, int sc) {
    *(LAS u32x4*)(buf + KSWZ(sr, sc * 2)) = s.k0; *(LAS u32x4*)(buf + KSWZ(32 + sr, sc * 2)) = s.k1;
    *(LAS u32x4*)(buf + KT_BYTES + sr * VP + sc * 2) = s.v0; *(LAS u32x4*)(buf + KT_BYTES + (32 + sr) * VP + sc * 2) = s.v1;
}
DI void qk_tile(f32x16& p0, f32x16& p1, const LAS unsigned char* Ks, const bf16x8 (&qr)[8], int r32, int hw, float ks, float base) {
    float ksl = ks; asm volatile("" : "+v"(ksl));
#pragma unroll
    for (int i = 0; i < 16; ++i) { p0[i] = fmaf(ksl, (float)CRC(i), base); p1[i] = fmaf(ksl, (float)(CRC(i) + 32), base); }
    const int x = (r32 & 7) << 4, lo4 = (hw << 4) ^ (x & 0x10);
    const LAS unsigned char* kb[4];
#pragma unroll
    for (int k = 0; k < 4; ++k) kb[k] = Ks + r32 * 256 + (((k << 5) ^ (x & 0x60)) | lo4);
#pragma unroll
    for (int hb = 0; hb < 2; ++hb) {
        bf16x8 a0[4], a1[4];
#pragma unroll
        for (int k = 0; k < 4; ++k) { a0[k] = *(const LAS bf16x8*)(kb[k] + hb * 128); a1[k] = *(const LAS bf16x8*)(kb[k] + hb * 128 + 8192); }
        asm volatile("s_waitcnt lgkmcnt(0)" ::: "memory"); __builtin_amdgcn_sched_barrier(0);
#pragma unroll
        for (int k = 0; k < 4; ++k) { p0 = MFMA32(a0[k], qr[4 * hb + k], p0); p1 = MFMA32(a1[k], qr[4 * hb + k], p1); }
        __builtin_amdgcn_sched_barrier(0);
    }
}
template <int OFF> DI s16x4 tr_read(unsigned vb) { s16x4 r; asm volatile("ds_read_b64_tr_b16 %0, %1 offset:%2" : "=&v"(r) : "v"(vb), "i"(OFF) : "memory"); return r; }
constexpr int v_off(int tt, int s, int half, int d0) { return tt * 32 * VP + s * 16 * VP + half * 8 * VP + d0 * 64; }
DI unsigned v_rd_base(const LAS unsigned char* Vs, int lane) { const int q = (lane & 15) >> 2, p = lane & 3, blk = (lane >> 4) & 1, hw = lane >> 5; return (unsigned)(uintptr_t)Vs + (4 * hw + q) * VP + (16 * blk + 4 * p) * 2; }
template <int D0> DI void pv_one(f32x16& od, unsigned vb, bf16x8 pa, bf16x8 pb, bf16x8 pc, bf16x8 pd) {
    const s16x4 l0 = tr_read<v_off(0, 0, 0, D0)>(vb), h0 = tr_read<v_off(0, 0, 1, D0)>(vb), l1 = tr_read<v_off(0, 1, 0, D0)>(vb), h1 = tr_read<v_off(0, 1, 1, D0)>(vb);
    const s16x4 l2 = tr_read<v_off(1, 0, 0, D0)>(vb), h2 = tr_read<v_off(1, 0, 1, D0)>(vb), l3 = tr_read<v_off(1, 1, 0, D0)>(vb), h3 = tr_read<v_off(1, 1, 1, D0)>(vb);
    asm volatile("s_waitcnt lgkmcnt(0)" ::: "memory"); __builtin_amdgcn_sched_barrier(0);
#define PKV(L, H) (bf16x8){L[0], L[1], L[2], L[3], H[0], H[1], H[2], H[3]}
    od = MFMA32(PKV(l0, h0), pa, od); od = MFMA32(PKV(l1, h1), pb, od); od = MFMA32(PKV(l2, h2), pc, od); od = MFMA32(PKV(l3, h3), pd, od);
#undef PKV
}
DI void pv_tile(f32x16 (&o)[4], unsigned vb, bf16x8 pa, bf16x8 pb, bf16x8 pc, bf16x8 pd) {
    pv_one<0>(o[0], vb, pa, pb, pc, pd); pv_one<1>(o[1], vb, pa, pb, pc, pd); pv_one<2>(o[2], vb, pa, pb, pc, pd); pv_one<3>(o[3], vb, pa, pb, pc, pd);
}
DI float half_max(float v) { auto rr = __builtin_amdgcn_permlane32_swap(__float_as_uint(v), __float_as_uint(v), false, false); return fmaxf(__uint_as_float(rr[0]), __uint_as_float(rr[1])); }
DI float half_sum(float v) { auto rr = __builtin_amdgcn_permlane32_swap(__float_as_uint(v), __float_as_uint(v), false, false); return __uint_as_float(rr[0]) + __uint_as_float(rr[1]); }
DI bf16x8 pack_half(const f32x16& p, int s) {
    u32x4 w; w.x = pk2(p[8 * s + 0], p[8 * s + 1]); w.y = pk2(p[8 * s + 2], p[8 * s + 3]); w.z = pk2(p[8 * s + 4], p[8 * s + 5]); w.w = pk2(p[8 * s + 6], p[8 * s + 7]);
    return __builtin_bit_cast(bf16x8, w);
}
template <bool MASK> DI float mask_max(f32x16& p0, f32x16& p1, int lo_, int hi_) {
    float mx = MASKV;
#pragma unroll
    for (int r = 0; r < 16; ++r) { if (MASK) p0[r] = (CRC(r) >= lo_ && CRC(r) <= hi_) ? p0[r] : MASKV; mx = fmaxf(mx, p0[r]); }
#pragma unroll
    for (int r = 0; r < 16; ++r) { if (MASK) p1[r] = (CRC(r) + 32 >= lo_ && CRC(r) + 32 <= hi_) ? p1[r] : MASKV; mx = fmaxf(mx, p1[r]); }
    return mx;
}
template <bool MASK> DI void softmax_tile(f32x16& p0, f32x16& p1, float& m, float& l, f32x16 (&o)[4], int lo_, int hi_,
                                          bf16x8& pa, bf16x8& pb, bf16x8& pc, bf16x8& pd) {
    const float mx = half_max(mask_max<MASK>(p0, p1, lo_, hi_));
    {
        const float mn = fmaxf(m, mx), alpha = __builtin_amdgcn_exp2f(m - mn);
#pragma unroll
        for (int d = 0; d < 4; ++d)
#pragma unroll
            for (int r = 0; r < 16; ++r) o[d][r] *= alpha;
        l *= alpha; m = mn;
    }
    float ps = 0.f;
#pragma unroll
    for (int r = 0; r < 16; ++r) { p0[r] = __builtin_amdgcn_exp2f(p0[r] - m); ps += p0[r]; }
#pragma unroll
    for (int r = 0; r < 16; ++r) { p1[r] = __builtin_amdgcn_exp2f(p1[r] - m); ps += p1[r]; }
    l += half_sum(ps);
    pa = pack_half(p0, 0); pb = pack_half(p0, 1); pc = pack_half(p1, 0); pd = pack_half(p1, 1);
}
DI void store_o(bf16_t* orow  , const f32x16 (&o)[4], float sc, int hw, bool accumulate) {
#pragma unroll
    for (int d0 = 0; d0 < 4; ++d0)
#pragma unroll
        for (int g = 0; g < 4; ++g) {
            u32x2* p = (u32x2*)(orow + 32 * d0 + 8 * g + 4 * hw);
            float a = o[d0][4 * g] * sc, b = o[d0][4 * g + 1] * sc, c = o[d0][4 * g + 2] * sc, d = o[d0][4 * g + 3] * sc;
            if (accumulate) { const u32x2 old = *p; a += bflo(old.x); b += bfhi(old.x); c += bflo(old.y); d += bfhi(old.y); }
            u32x2 w; w.x = pk2(a, b); w.y = pk2(c, d); *p = w;
        }
}
DI void zero_o(f32x16 (&o)[4]) {
#pragma unroll
    for (int d = 0; d < 4; ++d)
#pragma unroll
        for (int r = 0; r < 16; ++r) o[d][r] = 0.f;
}

DI bool better(float av, int ai, float bv, int bi) { return av > bv || (av == bv && ai < bi); }
DI void ins3(float v, int i, float& v1, int& i1, float& v2, int& i2, float& v3, int& i3) {
    const bool b1 = better(v, i, v1, i1), b2 = better(v, i, v2, i2), b3 = better(v, i, v3, i3);
    const float n3v = b2 ? v2 : (b3 ? v : v3); const int n3i = b2 ? i2 : (b3 ? i : i3);
    const float n2v = b1 ? v1 : (b2 ? v : v2); const int n2i = b1 ? i1 : (b2 ? i : i2);
    const float n1v = b1 ? v : v1; const int n1i = b1 ? i : i1;
    v1 = n1v; i1 = n1i; v2 = n2v; i2 = n2i; v3 = n3v; i3 = n3i;
}
DI void moba_store_partial(const PArgs& P, int b, int t, int h, int rank, const f32x16 (&o)[4], float m, float l, int hw) {
    const size_t pi = ((size_t)(b * NT + t) * 8 + h) * 4 + rank;
    store_o((bf16_t*)P.out + pi * HD, o, l > 0.f ? 1.0f / l : 0.f, hw, false);
    if (hw == 0) { f32x2 v = {m, l}; ((f32x2*)(P.ws + WS_ML))[pi] = v; }
}
DI void moba_gate_unit(const PArgs& P, int b, int h, int bt) {
    int tid = P.tid; asm volatile("" : "+v"(tid));
    const int lane = tid & 63, wave = P.wave, r32 = lane & 31, hw = lane >> 5;
    unsigned char* ws = P.ws;
    const int t = bt * 256 + wave * 32 + r32;
    const bf16_t* Q = (const bf16_t*)(ws + WS_MQ) + ((size_t)(b * NT + t) * 8 + h) * HD + hw * 8;
    bf16x8 qr[8];
#pragma unroll
    for (int d0 = 0; d0 < 8; ++d0) qr[d0] = *(const bf16x8*)(Q + 16 * d0);
    const float slope2 = __int_as_float(__builtin_amdgcn_readfirstlane(__float_as_int(exp2f(-((float)h + 0.5f)) * LOG2E)));
    LAS unsigned* gcnt = (LAS unsigned*)(P.lds + 134144);
    LAS unsigned* gbase = gcnt + 32;
    if (tid < 32) gcnt[tid] = 0u;
    __syncthreads();
    const bf16_t* Kb = (const bf16_t*)(ws + WS_MK) + ((size_t)(b * NT + bt * 256) * 8 + h) * HD;
    const bf16_t* Vb = (const bf16_t*)(ws + WS_MV) + ((size_t)(b * NT + bt * 256) * 8 + h) * HD;
    Stage st; stage_load(st, Kb, Vb, 1024, tid >> 4, (tid & 15) * 8);
    {
        const float NINF = -__builtin_inff();
        float v1 = NINF, v2 = NINF, v3 = NINF; int i1 = 99, i2 = 100, i3 = 101;
        if (bt > 0) {
            f32x16 g;
#pragma unroll
            for (int i = 0; i < 16; ++i) g[i] = 0.f;
            const bf16_t* km = (const bf16_t*)(ws + WS_KMEAN) + ((size_t)(b * 8 + h) * 32 + r32) * HD + hw * 8;
#pragma unroll
            for (int d0 = 0; d0 < 8; ++d0) g = MFMA32(*(const bf16x8*)(km + 16 * d0), qr[d0], g);
#pragma unroll
            for (int i = 0; i < 16; ++i) { const int blk = CRC(i) + 4 * hw; const float v = blk < bt ? g[i] : NINF; ins3(v, blk, v1, i1, v2, i2, v3, i3); }
            const float w1 = __shfl_xor(v1, 32), w2 = __shfl_xor(v2, 32), w3 = __shfl_xor(v3, 32);
            const int j1 = __shfl_xor(i1, 32), j2 = __shfl_xor(i2, 32), j3 = __shfl_xor(i3, 32);
            ins3(w1, j1, v1, i1, v2, i2, v3, i3); ins3(w2, j2, v1, i1, v2, i2, v3, i3); ins3(w3, j3, v1, i1, v2, i2, v3, i3);
        }
        if (hw == 0) {
            const size_t pi = ((size_t)(b * NT + t) * 8 + h) * 4; f32x2 e = {MINIT, 0.f};
            ((f32x2*)(ws + WS_ML))[pi] = e; ((f32x2*)(ws + WS_ML))[pi + 1] = e; ((f32x2*)(ws + WS_ML))[pi + 2] = e;
        }
        unsigned s1 = 0u, s2 = 0u, s3 = 0u;
        if (hw == 0) {
            if (v1 > NINF) s1 = __hip_atomic_fetch_add(gcnt + i1, 1u, __ATOMIC_RELAXED, __HIP_MEMORY_SCOPE_WORKGROUP);
            if (v2 > NINF) s2 = __hip_atomic_fetch_add(gcnt + i2, 1u, __ATOMIC_RELAXED, __HIP_MEMORY_SCOPE_WORKGROUP);
            if (v3 > NINF) s3 = __hip_atomic_fetch_add(gcnt + i3, 1u, __ATOMIC_RELAXED, __HIP_MEMORY_SCOPE_WORKGROUP);
        }
        __syncthreads();
        if (tid < 32) { const unsigned c = gcnt[tid]; gbase[tid] = c ? atomicAdd((unsigned*)(ws + WS_CTL) + CTLW_LCNT + (b * 8 + h) * 32 + tid, c) : 0u; }
        __syncthreads();
        if (hw == 0) {
            int* lists = (int*)(ws + WS_LIST) + (size_t)((b * 8 + h) * 32) * 8192;
            if (v1 > NINF) lists[(size_t)i1 * 8192 + gbase[i1] + s1] = t | (0 << 16);
            if (v2 > NINF) lists[(size_t)i2 * 8192 + gbase[i2] + s2] = t | (1 << 16);
            if (v3 > NINF) lists[(size_t)i3 * 8192 + gbase[i3] + s3] = t | (2 << 16);
        }
    }
    float m = MINIT, l = 0.f; f32x16 o[4]; zero_o(o);
#pragma unroll
    for (int kt = 0; kt < 4; ++kt) {
        int tz = tid; asm volatile("" : "+v"(tz));
        const int lz = tz & 63, r32z = lz & 31, hwz = lz >> 5, srz = tz >> 4, scz = (tz & 15) * 8;
        LAS unsigned char* buf = P.lds + (kt & 1) * BUF_BYTES;
        stage_write(st, buf, srz, scz);
        __syncthreads();
        if (kt + 1 < 4) stage_load(st, Kb + (size_t)(64 * (kt + 1)) * 1024, Vb + (size_t)(64 * (kt + 1)) * 1024, 1024, srz, scz);
        const int q0 = wave * 32;
        {
            f32x16 p0, p1; bf16x8 pa, pb, pc, pd;
            qk_tile(p0, p1, buf, qr, r32z, hwz, slope2, slope2 * (float)(64 * kt + 4 * hwz - (q0 + r32z)));
            softmax_tile<true>(p0, p1, m, l, o, -1000 - 4 * hwz, q0 + r32z - kt * 64 - 4 * hwz, pa, pb, pc, pd);
            pv_tile(o, v_rd_base(buf + KT_BYTES, lz), pa, pb, pc, pd);
        }
    }
    { int tz = tid; asm volatile("" : "+v"(tz)); const int lz = tz & 63; moba_store_partial(P, b, bt * 256 + wave * 32 + (lz & 31), h, 3, o, m, l, lz >> 5); }
    __syncthreads();
}
DI void moba_item(const PArgs& P, int lid, int c256) {
    unsigned char* ws = P.ws;
    const int cnt = (int)__hip_atomic_load((const unsigned*)(ws + WS_CTL) + CTLW_LCNT + lid, __ATOMIC_RELAXED, __HIP_MEMORY_SCOPE_AGENT);
    if (c256 * 256 >= cnt) return;
    int tid = P.tid; asm volatile("" : "+v"(tid));
    const int lane = tid & 63, wave = P.wave, r32 = lane & 31, hw = lane >> 5;
    const int b = lid >> 8, h = (lid >> 5) & 7, j = lid & 31;
    const int idx = c256 * 256 + wave * 32 + r32; const bool act = idx < cnt;
    const int ent = act ? ((const int*)(ws + WS_LIST))[(size_t)lid * 8192 + idx] : 0;
    const int t = ent & 0xffff, rank = ent >> 16;
    const bf16_t* Q = (const bf16_t*)(ws + WS_MQ) + ((size_t)(b * NT + t) * 8 + h) * HD + hw * 8;
    bf16x8 qr[8];
#pragma unroll
    for (int d0 = 0; d0 < 8; ++d0) qr[d0] = *(const bf16x8*)(Q + 16 * d0);
    const float slope2 = __int_as_float(__builtin_amdgcn_readfirstlane(__float_as_int(exp2f(-((float)h + 0.5f)) * LOG2E)));
    float m = MINIT, l = 0.f; f32x16 o[4]; zero_o(o);
    const bf16_t* Kb = (const bf16_t*)(ws + WS_MK) + ((size_t)(b * NT + j * 256) * 8 + h) * HD;
    const bf16_t* Vb = (const bf16_t*)(ws + WS_MV) + ((size_t)(b * NT + j * 256) * 8 + h) * HD;
    Stage st; stage_load(st, Kb, Vb, 1024, tid >> 4, (tid & 15) * 8);
#pragma unroll
    for (int kt = 0; kt < 4; ++kt) {
        int tz = tid; asm volatile("" : "+v"(tz));
        const int lz = tz & 63, r32z = lz & 31, hwz = lz >> 5, srz = tz >> 4, scz = (tz & 15) * 8;
        LAS unsigned char* buf = P.lds + (kt & 1) * BUF_BYTES;
        stage_write(st, buf, srz, scz);
        __syncthreads();
        if (kt + 1 < 4) stage_load(st, Kb + (size_t)(64 * (kt + 1)) * 1024, Vb + (size_t)(64 * (kt + 1)) * 1024, 1024, srz, scz);
        {
            f32x16 p0, p1; bf16x8 pa, pb, pc, pd;
            qk_tile(p0, p1, buf, qr, r32z, hwz, slope2, act ? slope2 * (float)(256 * j + 64 * kt + 4 * hwz - t) : MASKV);
            softmax_tile<false>(p0, p1, m, l, o, 0, 0, pa, pb, pc, pd);
            pv_tile(o, v_rd_base(buf + KT_BYTES, lz), pa, pb, pc, pd);
        }
    }
    if (act) { int tz = tid; asm volatile("" : "+v"(tz)); moba_store_partial(P, b, t, h, rank, o, m, l, (tz & 63) >> 5); }
    __syncthreads();
}
DI void moba_combine(const PArgs& P) {
    const int gw = P.wg * NWAVES + P.wave, NGW = P.G * NWAVES, lane = P.lane, h = lane >> 3, dc = lane & 7;
    const bf16_t* Op = (const bf16_t*)P.out; const f32x2* ML = (const f32x2*)(P.ws + WS_ML); bf16_t* hb = (bf16_t*)(P.ws + WS_HB);
    for (int tok = gw; tok < NTOK; tok += NGW) {
        const size_t pi = ((size_t)tok * 8 + h) * 4;
        f32x2 ml[4]; float M = MINIT;
#pragma unroll
        for (int r = 0; r < 4; ++r) { ml[r] = ML[pi + r]; M = fmaxf(M, ml[r].x); }
        float w[4], ws_ = 0.f;
#pragma unroll
        for (int r = 0; r < 4; ++r) { w[r] = ml[r].y * __builtin_amdgcn_exp2f(ml[r].x - M); ws_ += w[r]; }
        const float inv = ws_ > 0.f ? 1.0f / ws_ : 0.f;
        float acc[16];
#pragma unroll
        for (int i = 0; i < 16; ++i) acc[i] = 0.f;
#pragma unroll
        for (int r = 0; r < 4; ++r) {
            const u32x4* p = (const u32x4*)(Op + (pi + r) * HD + dc * 16); const u32x4 a = p[0], c = p[1]; const float wr_ = w[r] * inv;
            if (w[r] > 0.f) {
                acc[0] += wr_ * bflo(a.x); acc[1] += wr_ * bfhi(a.x); acc[2] += wr_ * bflo(a.y); acc[3] += wr_ * bfhi(a.y); acc[4] += wr_ * bflo(a.z); acc[5] += wr_ * bfhi(a.z); acc[6] += wr_ * bflo(a.w); acc[7] += wr_ * bfhi(a.w);
                acc[8] += wr_ * bflo(c.x); acc[9] += wr_ * bfhi(c.x); acc[10] += wr_ * bflo(c.y); acc[11] += wr_ * bfhi(c.y); acc[12] += wr_ * bflo(c.z); acc[13] += wr_ * bfhi(c.z); acc[14] += wr_ * bflo(c.w); acc[15] += wr_ * bfhi(c.w);
            }
        }
        float ss = 0.f;
#pragma unroll
        for (int i = 0; i < 16; ++i) ss += acc[i] * acc[i];
        ss = wave_sum(ss);
        const float rs = 1.0f / sqrtf(ss * (1.0f / 1024.f) + EPS);
        u32x4 o0, o1;
#if F8G3
        { u32x4 o8; o8.x = pk4_f8(acc[0] * rs, acc[1] * rs, acc[2] * rs, acc[3] * rs); o8.y = pk4_f8(acc[4] * rs, acc[5] * rs, acc[6] * rs, acc[7] * rs); o8.z = pk4_f8(acc[8] * rs, acc[9] * rs, acc[10] * rs, acc[11] * rs); o8.w = pk4_f8(acc[12] * rs, acc[13] * rs, acc[14] * rs, acc[15] * rs);
          *(u32x4*)(P.ws + WS_HB8 + (size_t)tok * DM + h * HD + dc * 16) = o8; (void)hb; }
#else
        o0.x = pk2(acc[0] * rs, acc[1] * rs); o0.y = pk2(acc[2] * rs, acc[3] * rs); o0.z = pk2(acc[4] * rs, acc[5] * rs); o0.w = pk2(acc[6] * rs, acc[7] * rs);
        o1.x = pk2(acc[8] * rs, acc[9] * rs); o1.y = pk2(acc[10] * rs, acc[11] * rs); o1.z = pk2(acc[12] * rs, acc[13] * rs); o1.w = pk2(acc[14] * rs, acc[15] * rs);
        u32x4* dst = (u32x4*)(hb + (size_t)tok * DM + h * HD + dc * 16); dst[0] = o0; dst[1] = o1;
#endif
    }
}
}
namespace att {
DI float dpp_quad_sum(float v) {
    int x = __float_as_int(v);
    v += __int_as_float(__builtin_amdgcn_mov_dpp(x, 0xB1, 0xf, 0xf, true));
    x = __float_as_int(v);
    v += __int_as_float(__builtin_amdgcn_mov_dpp(x, 0x4E, 0xf, 0xf, true));
    return v;
}
DI void lds_addf(LAS float* p, float v) { (void)__hip_atomic_fetch_add(p, v, __ATOMIC_RELAXED, __HIP_MEMORY_SCOPE_WORKGROUP); }

DI void nsa_unit(const PArgs& P, int b, int g, int c) {
    int tid = P.tid; asm volatile("" : "+v"(tid));
    const int lane = tid & 63, wave = P.wave, r32 = lane & 31, hw = lane >> 5;
    unsigned char* ws = P.ws;
    const int t0 = 64 * c, tl = wave * 8 + (r32 >> 2), t = t0 + tl, head = g * 4 + (r32 & 3);
    const bf16_t* Q = (const bf16_t*)(ws + WS_NQ) + ((size_t)(b * NT + t) * 8 + head) * HD + hw * 8;
    bf16x8 qr[8];
#pragma unroll
    for (int d0 = 0; d0 < 8; ++d0) qr[d0] = *(const bf16x8*)(Q + 16 * d0);
    const float slope2 = exp2f(-(float)(head + 1)) * LOG2E;
    const float* gp = (const float*)(ws + WS_GATES) + (size_t)(b * NT + t) * 24 + head * 3;
    const float g0 = gp[0], g1 = gp[1], g2 = gp[2];
    bf16_t* orow = (bf16_t*)(ws + WS_HB) + (size_t)(b * NT + t) * DM + 1024 + head * HD;
    LAS float* imp = (LAS float*)(P.lds + SCR_OFF);
    LAS unsigned* selm = (LAS unsigned*)(P.lds + SCR_OFF + 32768);
    LAS unsigned* uni = selm + 256;
    LAS int* blist = (LAS int*)(uni + 4);
    for (int i = tid; i < 64 * 128; i += NTHR) imp[i] = 0.f;
    if (tid < 4) uni[tid] = 0u;
    const int sr = tid >> 4, sc = (tid & 15) * 8;
    const size_t slab = (size_t)(b * 2 + g);
    float m = MINIT, l = 0.f; f32x16 o[4];
    {
        const bf16_t* Kb = (const bf16_t*)(ws + WS_KCMP) + slab * 512 * HD; const bf16_t* Vb = (const bf16_t*)(ws + WS_VCMP) + slab * 512 * HD;
        const int nkeys = (4 * c + 3) < 511 ? (4 * c + 3) : 511, ntl = (nkeys + 63) >> 6;
        const int nlim = t >= 31 ? ((t - 31) >> 4) : -1;
        const float ksc = slope2 * 16.f, b0 = slope2 * (float)(31 - t);
        Stage st; stage_load(st, Kb, Vb, HD, sr, sc);
        for (int ti = 0; ti < ntl; ++ti) {
            LAS unsigned char* buf = P.lds + (ti & 1) * BUF_BYTES;
            stage_write(st, buf, sr, sc);
            __syncthreads();
            if (ti + 1 < ntl) stage_load(st, Kb + (size_t)(64 * (ti + 1)) * HD, Vb + (size_t)(64 * (ti + 1)) * HD, HD, sr, sc);
            f32x16 p0, p1; qk_tile(p0, p1, buf, qr, r32, hw, ksc, ksc * (float)(64 * ti + 4 * hw) + b0);
            const float mx = half_max(mask_max<true>(p0, p1, -1000 - 4 * hw, nlim - 64 * ti - 4 * hw));
            const float mn = fmaxf(m, mx);
            float ps = 0.f;
#pragma unroll
            for (int r = 0; r < 16; ++r) ps += __builtin_amdgcn_exp2f(p0[r] - mn) + __builtin_amdgcn_exp2f(p1[r] - mn);
            l = l * __builtin_amdgcn_exp2f(m - mn) + half_sum(ps); m = mn;
        }
        __syncthreads();
        const float invl = l > 0.f ? 1.0f / l : 0.f;
        zero_o(o);
        stage_load(st, Kb, Vb, HD, sr, sc);
        for (int ti = 0; ti < ntl; ++ti) {
            LAS unsigned char* buf = P.lds + (ti & 1) * BUF_BYTES;
            stage_write(st, buf, sr, sc);
            __syncthreads();
            if (ti + 1 < ntl) stage_load(st, Kb + (size_t)(64 * (ti + 1)) * HD, Vb + (size_t)(64 * (ti + 1)) * HD, HD, sr, sc);
            f32x16 p0, p1; qk_tile(p0, p1, buf, qr, r32, hw, ksc, ksc * (float)(64 * ti + 4 * hw) + b0);
            (void)mask_max<true>(p0, p1, -1000 - 4 * hw, nlim - 64 * ti - 4 * hw);
#pragma unroll
            for (int r = 0; r < 16; ++r) { p0[r] = __builtin_amdgcn_exp2f(p0[r] - m) * invl; p1[r] = __builtin_amdgcn_exp2f(p1[r] - m) * invl; }
#pragma unroll
            for (int hf = 0; hf < 2; ++hf)
#pragma unroll
                for (int gq = 0; gq < 4; ++gq) {
                    const f32x16& pp = hf ? p1 : p0;
                    float s4 = (pp[4 * gq] + pp[4 * gq + 1]) + (pp[4 * gq + 2] + pp[4 * gq + 3]), s1 = pp[4 * gq + 3];
                    s4 = dpp_quad_sum(s4); s1 = dpp_quad_sum(s1);
                    const int sblk = 16 * ti + 8 * hf + 2 * gq + hw;
                    if ((r32 & 3) == 0) { lds_addf(imp + tl * 128 + sblk, s4); if (sblk + 1 < 128) lds_addf(imp + tl * 128 + sblk + 1, s1); }
                }
            const bf16x8 pa = pack_half(p0, 0), pb = pack_half(p0, 1), pc = pack_half(p1, 0), pd = pack_half(p1, 1);
            pv_tile(o, v_rd_base(buf + KT_BYTES, lane), pa, pb, pc, pd);
        }
        store_o(orow, o, g0, hw, false);
    }
    __syncthreads();
    {
        for (int tk = 0; tk < 8; ++tk) {
            const int tok = wave * 8 + tk;
            unsigned long long m0, m1;
            if (c + 1 <= 16) { m0 = (c >= 63) ? ~0ull : ((1ull << (c + 1)) - 1ull); m1 = 0ull; }
            else {
                const int s0 = lane, s1 = lane + 64;
                const bool c0 = (s0 >= 1 && s0 <= c - 2), c1 = (s1 <= c - 2);
                const unsigned k0 = c0 ? __float_as_uint(imp[tok * 128 + s0]) : 0u, k1 = c1 ? __float_as_uint(imp[tok * 128 + s1]) : 0u;
                const int R = 13;
                unsigned thr = 0u;
                for (int bit = 31; bit >= 0; --bit) {
                    const unsigned tt = thr | (1u << bit);
                    const int cn = __builtin_popcountll(__builtin_amdgcn_ballot_w64(c0 && k0 >= tt)) + __builtin_popcountll(__builtin_amdgcn_ballot_w64(c1 && k1 >= tt));
                    if (cn >= R) thr = tt;
                }
                const unsigned long long gt0 = __builtin_amdgcn_ballot_w64(c0 && k0 > thr), gt1 = __builtin_amdgcn_ballot_w64(c1 && k1 > thr);
                const unsigned long long eq0 = __builtin_amdgcn_ballot_w64(c0 && k0 == thr), eq1 = __builtin_amdgcn_ballot_w64(c1 && k1 == thr);
                int need = R - (__builtin_popcountll(gt0) + __builtin_popcountll(gt1));
                unsigned long long e0 = eq0, e1 = eq1, t0m = 0ull, t1m = 0ull;
                const int n0 = __builtin_popcountll(e0);
                if (need >= n0) { t0m = e0; need -= n0; } else { while (need > 0) { const unsigned long long low = e0 & (0ull - e0); t0m |= low; e0 ^= low; --need; } }
                if (need > 0) { while (need > 0 && e1) { const unsigned long long low = e1 & (0ull - e1); t1m |= low; e1 ^= low; --need; } }
                m0 = gt0 | t0m; m1 = gt1 | t1m;
                m0 |= 1ull;
                if (c < 64) m0 |= 1ull << c; else m1 |= 1ull << (c - 64);
                if (c - 1 < 64) m0 |= 1ull << (c - 1); else m1 |= 1ull << (c - 1 - 64);
            }
            if (lane == 0) {
                selm[tok * 4 + 0] = (unsigned)m0; selm[tok * 4 + 1] = (unsigned)(m0 >> 32); selm[tok * 4 + 2] = (unsigned)m1; selm[tok * 4 + 3] = (unsigned)(m1 >> 32);
                (void)__hip_atomic_fetch_or(uni + 0, (unsigned)m0, __ATOMIC_RELAXED, __HIP_MEMORY_SCOPE_WORKGROUP); (void)__hip_atomic_fetch_or(uni + 1, (unsigned)(m0 >> 32), __ATOMIC_RELAXED, __HIP_MEMORY_SCOPE_WORKGROUP);
                (void)__hip_atomic_fetch_or(uni + 2, (unsigned)m1, __ATOMIC_RELAXED, __HIP_MEMORY_SCOPE_WORKGROUP); (void)__hip_atomic_fetch_or(uni + 3, (unsigned)(m1 >> 32), __ATOMIC_RELAXED, __HIP_MEMORY_SCOPE_WORKGROUP);
            }
        }
    }
    __syncthreads();
    if (tid == 0) { int n = 0; for (int w = 0; w < 4; ++w) { unsigned u = uni[w]; while (u) { const int bpos = __builtin_ctz(u); blist[n++] = 32 * w + bpos; u &= u - 1u; } } blist[128] = n; }
    __syncthreads();
    const unsigned my0 = selm[tl * 4 + 0], my1 = selm[tl * 4 + 1], my2 = selm[tl * 4 + 2], my3 = selm[tl * 4 + 3];
#define NSA_STEP(IDX, HAVE_NEXT, KNEXT, VNEXT, MASKED, LO, HI, JPOS, ON) do { \
        LAS unsigned char* buf = P.lds + ((IDX) & 1) * BUF_BYTES; \
        stage_write(st, buf, sr, sc); \
        __syncthreads(); \
        if (HAVE_NEXT) stage_load(st, (KNEXT), (VNEXT), HD, sr, sc); \
        if (__builtin_amdgcn_ballot_w64(ON) != 0ull) {     \
        f32x16 p0, p1; bf16x8 pa, pb, pc, pd; \
        qk_tile(p0, p1, buf, qr, r32, hw, slope2, (ON) ? slope2 * (float)(64 * (JPOS) + 4 * hw - t) : MASKV); \
        softmax_tile<MASKED>(p0, p1, m, l, o, (LO), (HI), pa, pb, pc, pd); \
        pv_tile(o, v_rd_base(buf + KT_BYTES, lane), pa, pb, pc, pd); } } while (0)
    {
        const bf16_t* Kb = (const bf16_t*)(ws + WS_KS) + slab * NT * HD; const bf16_t* Vb = (const bf16_t*)(ws + WS_VS) + slab * NT * HD;
        const int nb = blist[128];
        m = MINIT; l = 0.f; zero_o(o);
        Stage st; { const int j0 = blist[0]; stage_load(st, Kb + (size_t)(64 * j0) * HD, Vb + (size_t)(64 * j0) * HD, HD, sr, sc); }
        for (int bi = 0; bi + 1 < nb; ++bi) {
            const int j = blist[bi], jn = blist[bi + 1];
            const unsigned wsel = (j < 32) ? my0 : (j < 64) ? my1 : (j < 96) ? my2 : my3;
            const bool on = (wsel >> (j & 31)) & 1u;
            NSA_STEP(bi, true, Kb + (size_t)(64 * jn) * HD, Vb + (size_t)(64 * jn) * HD, false, 0, 0, j, on);
        }
        NSA_STEP(nb - 1, false, Kb, Vb, true, -1000 - 4 * hw, tl - 4 * hw, c, true);
        store_o(orow, o, l > 0.f ? g1 / l : 0.f, hw, true);
    }
    __syncthreads();
    {
        const bf16_t* Kb = (const bf16_t*)(ws + WS_KW) + slab * NT * HD; const bf16_t* Vb = (const bf16_t*)(ws + WS_VW) + slab * NT * HD;
        m = MINIT; l = 0.f; zero_o(o);
        int idx = 0;
        const int jfirst = c >= 8 ? c - 8 : 0;
        Stage st; stage_load(st, Kb + (size_t)(64 * jfirst) * HD, Vb + (size_t)(64 * jfirst) * HD, HD, sr, sc);
        if (c >= 8) { NSA_STEP(idx, true, Kb + (size_t)(64 * (c - 7)) * HD, Vb + (size_t)(64 * (c - 7)) * HD, true, tl + 1 - 4 * hw, 1000, c - 8, true); ++idx; }
        for (int j = (c >= 8 ? c - 7 : 0); j < c; ++j) { NSA_STEP(idx, true, Kb + (size_t)(64 * (j + 1)) * HD, Vb + (size_t)(64 * (j + 1)) * HD, false, 0, 0, j, true); ++idx; }
        NSA_STEP(idx, false, Kb, Vb, true, -1000 - 4 * hw, tl - 4 * hw, c, true);
        store_o(orow, o, l > 0.f ? g2 / l : 0.f, hw, true);
    }
#undef NSA_STEP
    __syncthreads();
}
}
DI void kmean_items(const PArgs& P, int w0, int nw) {
    const bf16_t* mk = (const bf16_t*)(P.ws + WS_MK); bf16_t* km = (bf16_t*)(P.ws + WS_KMEAN);
    for (int it = w0; it < NB * 8 * 32; it += nw) {
        const int b = it >> 8, h = (it >> 5) & 7, blk = it & 31;
        const unsigned* src = (const unsigned*)(mk + ((size_t)(b * NT + blk * 256) * 8 + h) * HD) + P.lane;
        float s0 = 0.f, s1 = 0.f;
#pragma unroll 8
        for (int k = 0; k < 256; ++k) { const unsigned u = src[(size_t)k * 512]; s0 += bflo(u); s1 += bfhi(u); }
        ((unsigned*)(km + (size_t)it * HD))[P.lane] = pk2(s0 * (1.0f / 256.f), s1 * (1.0f / 256.f));
    }
}
DI float gelu_tanh(float x) { const float u = 0.7978845608028654f * (x + 0.044715f * x * x * x); const float e = __expf(2.f * u); return 0.5f * x * (1.f + (1.f - 2.f / (1.f + e))); }
DI void compress2_items(const PArgs& P) {
    const int gw = P.wg * NWAVES + P.wave, NGW = P.G * NWAVES, lane = P.lane;
    LAS float* w2s = (LAS float*)P.lds;
    LAS float* hid = (LAS float*)(P.lds + 65536 + P.wave * 512);
    for (int kv = 0; kv < 2; ++kv) {
        { const f32x4* w2 = (const f32x4*)INP(kv ? I_W2V : I_W2K);
          for (int i = P.tid; i < 128 * 128 / 4; i += NTHR) *(LAS f32x4*)(w2s + 4 * i) = w2[i]; }
        __syncthreads();
        const float* Pm = (const float*)(P.ws + (kv ? WS_PV : WS_PK)); const float* bias = (const float*)(P.ws + WS_BIAS) + kv * 128;
        for (int row = gw; row < 4096; row += NGW) {
            const int c = row & 511;
            bf16_t* dst = (bf16_t*)(P.ws + (kv ? WS_VCMP : WS_KCMP)) + (size_t)row * HD;
            if (c == 511) { ((unsigned*)dst)[lane] = 0u; continue; }
            const float h0 = gelu_tanh(Pm[(size_t)row * 256 + lane] + Pm[(size_t)(row + 1) * 256 + 128 + lane] + bias[lane]);
            const float h1 = gelu_tanh(Pm[(size_t)row * 256 + 64 + lane] + Pm[(size_t)(row + 1) * 256 + 192 + lane] + bias[64 + lane]);
            hid[lane] = h0; hid[64 + lane] = h1;
            LDS_WAIT();
            float a0 = 0.f, a1 = 0.f;
#pragma unroll 16
            for (int n = 0; n < 128; ++n) { const float hv = hid[n]; const f32x2 w = *(const LAS f32x2*)(w2s + n * HD + 2 * lane); a0 = fmaf(hv, w.x, a0); a1 = fmaf(hv, w.y, a1); }
            ((unsigned*)dst)[lane] = pk2(a0, a1);
            LDS_WAIT();
        }
        __syncthreads();
    }
}
DI void outnorm_rows(const PArgs& P) {
    const int gw = P.wg * NWAVES + P.wave, NGW = P.G * NWAVES, lane = P.lane;
    bf16_t* hb = (bf16_t*)(P.ws + WS_HB);
    for (int row = gw; row < NTOK; row += NGW) {
        for (int grp = 1; grp < 2; ++grp) {
            u32x4* p = (u32x4*)(hb + (size_t)row * DM + grp * 1024) + lane;
            u32x4 a = p[0], c = p[64]; float v[16];
            v[0] = bflo(a.x); v[1] = bfhi(a.x); v[2] = bflo(a.y); v[3] = bfhi(a.y); v[4] = bflo(a.z); v[5] = bfhi(a.z); v[6] = bflo(a.w); v[7] = bfhi(a.w);
            v[8] = bflo(c.x); v[9] = bfhi(c.x); v[10] = bflo(c.y); v[11] = bfhi(c.y); v[12] = bflo(c.z); v[13] = bfhi(c.z); v[14] = bflo(c.w); v[15] = bfhi(c.w);
            float s = 0.f;
#pragma unroll
            for (int i = 0; i < 16; ++i) s += v[i] * v[i];
            s = wave_sum(s);
            const float rs = 1.0f / sqrtf(s * (1.0f / 1024.f) + EPS);
            a.x = pk2(v[0] * rs, v[1] * rs); a.y = pk2(v[2] * rs, v[3] * rs); a.z = pk2(v[4] * rs, v[5] * rs); a.w = pk2(v[6] * rs, v[7] * rs);
            c.x = pk2(v[8] * rs, v[9] * rs); c.y = pk2(v[10] * rs, v[11] * rs); c.z = pk2(v[12] * rs, v[13] * rs); c.w = pk2(v[14] * rs, v[15] * rs);
#if F8G3
            { unsigned char* q8 = P.ws + WS_HB8 + (size_t)row * DM + grp * 1024 + 8 * lane; u32x2 w0, w1;
              w0.x = pk4_f8(v[0] * rs, v[1] * rs, v[2] * rs, v[3] * rs); w0.y = pk4_f8(v[4] * rs, v[5] * rs, v[6] * rs, v[7] * rs); w1.x = pk4_f8(v[8] * rs, v[9] * rs, v[10] * rs, v[11] * rs); w1.y = pk4_f8(v[12] * rs, v[13] * rs, v[14] * rs, v[15] * rs);
              *(u32x2*)q8 = w0; *(u32x2*)(q8 + 512) = w1; }
#else
            p[0] = a; p[64] = c;
#endif
        }
    }
}
DI void router_tasks(const PArgs& P) {
    const int lane = P.lane, fr = lane & 15, fq = lane >> 4;
    unsigned char* ws = P.ws;
    const bf16_t* xb1 = (const bf16_t*)P.out; const bf16_t* wr = (const bf16_t*)(ws + WS_WR);
    const float* ssq1 = (const float*)(ws + WS_CTL + CTL_SSQ1); float* rs1 = (float*)(ws + WS_RS1);
    unsigned* cnt = (unsigned*)(ws + WS_CTL) + CTLW_CNT; int* tokl = (int*)(ws + WS_TOKL); float* asgw = (float*)(ws + WS_WL); float* rsl = (float*)(ws + WS_RSL); int* asg = (int*)(ws + WS_ASG);
    const float* rbias = INP(I_RBIAS);
    LAS float* la = (LAS float*)(P.lds + P.wave * 8448);
    LAS float* lb = la + 16 * 66;
    LAS unsigned* lcnt = (LAS unsigned*)(P.lds + NWAVES * 8448);
    LAS unsigned* lbase = lcnt + 64;
    for (int task0 = P.wg * NWAVES; task0 < NTOK / 16; task0 += P.G * NWAVES) {
        const int t0 = (task0 + P.wave) * 16;
        if (P.tid < 64) lcnt[P.tid] = 0u;
        f32x4 acc[4];
#pragma unroll
        for (int n = 0; n < 4; ++n) acc[n] = (f32x4){0.f, 0.f, 0.f, 0.f};
        const bf16_t* ap = xb1 + (size_t)(t0 + fr) * DM + fq * 8; const bf16_t* bp = wr + (size_t)fr * DM + fq * 8;
#pragma unroll 4
        for (int kk = 0; kk < 64; ++kk) {
            const bf16x8 a = *(const bf16x8*)(ap + 32 * kk);
#pragma unroll
            for (int n = 0; n < 4; ++n) { const bf16x8 bb = *(const bf16x8*)(bp + (size_t)(16 * n) * DM + 32 * kk); acc[n] = __builtin_amdgcn_mfma_f32_16x16x32_bf16(a, bb, acc[n], 0, 0, 0); }
        }
#pragma unroll
        for (int n = 0; n < 4; ++n)
#pragma unroll
            for (int j = 0; j < 4; ++j) la[(4 * fq + j) * 66 + 16 * n + fr] = acc[n][j];
        __syncthreads();
        int sel[8]; unsigned ls[8]; float wv[8]; float rs = 0.f;
#pragma unroll
        for (int r = 0; r < 8; ++r) { sel[r] = 0; ls[r] = 0u; wv[r] = 0.f; }
        if (lane < 16) {
            const int t = t0 + lane; LAS float* A = la + lane * 66; LAS float* Bv = lb + lane * 66;
            rs = 1.0f / sqrtf(ssq1[t] * (1.0f / DM) + EPS); rs1[t] = rs;
            for (int e = 0; e < 64; ++e) { const float a = 1.0f / (1.0f + __expf(-rs * A[e])); A[e] = a; Bv[e] = a + rbias[e]; }
            float gs[8];
#pragma unroll
            for (int gi = 0; gi < 8; ++gi) { float m1 = -1e30f, m2 = -1e30f; for (int k = 0; k < 8; ++k) { const float v = Bv[8 * gi + k]; if (v > m1) { m2 = m1; m1 = v; } else if (v > m2) m2 = v; } gs[gi] = m1 + m2; }
            unsigned gmask = 0u;
            for (int r = 0; r < 4; ++r) { float best = -1e30f; int bi = 0;
#pragma unroll
                for (int gi = 0; gi < 8; ++gi) { const bool ok = !((gmask >> gi) & 1u) && gs[gi] > best; if (ok) { best = gs[gi]; bi = gi; } }
                gmask |= 1u << bi; }
            unsigned long long taken = 0ull; float wsum = 0.f;
#pragma unroll
            for (int r = 0; r < 8; ++r) { float best = -1e30f; int bi = 0;
                for (int e = 0; e < 64; ++e) { const bool ok = ((gmask >> (e >> 3)) & 1u) && !((taken >> e) & 1ull) && Bv[e] > best; if (ok) { best = Bv[e]; bi = e; } }
                taken |= 1ull << bi; sel[r] = bi; wv[r] = A[bi]; wsum += A[bi]; }
            const float wn = 2.5f / wsum;
#pragma unroll
            for (int r = 0; r < 8; ++r) { wv[r] *= wn; ls[r] = __hip_atomic_fetch_add(lcnt + sel[r], 1u, __ATOMIC_RELAXED, __HIP_MEMORY_SCOPE_WORKGROUP); }
        }
        __syncthreads();
        if (P.tid < 64) { const unsigned c = lcnt[P.tid]; lbase[P.tid] = c ? atomicAdd(cnt + P.tid, c) : 0u; }
        __syncthreads();
        if (lane < 16) {
            const int t = t0 + lane;
#pragma unroll
            for (int r = 0; r < 8; ++r) { const int e = sel[r]; const unsigned slot = (lbase[e] + ls[r]) & 32767u; const size_t li = (size_t)e * 32768 + slot;
                tokl[li] = t; rsl[li] = rs; asg[t * 8 + r] = (e << 15) | (int)slot; asgw[t * 8 + r] = wv[r]; }
        }
    }
    __syncthreads();
}
DI void moe_tables(const PArgs& P, LAS int* tab) {
    if (P.wave == 0) {
        const unsigned* cnt = (const unsigned*)(P.ws + WS_CTL) + CTLW_CNT; const int e = P.lane;
        const int ce = (int)__hip_atomic_load(cnt + e, __ATOMIC_RELAXED, __HIP_MEMORY_SCOPE_AGENT); const int mt = (ce + 255) >> 8;
        int inc = mt;
#pragma unroll
        for (int o = 1; o < 64; o <<= 1) { const int v = __shfl_up(inc, o); if (e >= o) inc += v; }
        const int mo = inc - mt;
        tab[e] = ce; tab[80 + e] = mo; tab[160 + e] = mo * 256;
        if (e == 63) { tab[64] = NTOK; tab[80 + 64] = inc; tab[160 + 64] = PSH; tab[80 + 65] = inc + NTOK / 256; }
    }
    __syncthreads();
}
DI void combine_rows(const PArgs& P, const LAS int* tab, float ysc, int gw, int NGW) {
    const int lane = P.lane;
    const bf16_t* xres = (const bf16_t*)P.out; const unsigned char* Yp = P.ws + WS_YP; const int* asg = (const int*)(P.ws + WS_ASG); const float* asgw = (const float*)(P.ws + WS_WL);
    float* rs2 = (float*)(P.ws + WS_RS2);
    for (int t = gw; t < NTOK; t += NGW) {
        unsigned rows[8]; float wk[8];
#pragma unroll
        for (int k = 0; k < 8; ++k) { const int a = asg[t * 8 + k]; { const unsigned R = (unsigned)(tab[160 + (a >> 15)] + (a & 32767)); rows[k] = (R >> 8) * 524288u + (R & 255u) * 256u; }   wk[k] = ysc * asgw[t * 8 + k]; }
        float ss = 0.f;
#pragma unroll
        for (int j = 0; j < 2; ++j) {
            const int cl = j * 1024 + 16 * lane;
            const int a0 = (cl & ~255) + ((cl >> 6) & 3) * 32 + ((cl >> 4) & 3) * 8;
            const u32x4* xp = (const u32x4*)(xres + (size_t)t * DM + a0); u32x4* xo = (u32x4*)((bf16_t*)(P.ws + WS_X2B) + (size_t)t * DM + a0);
            const u32x4 xa = xp[0], xb = xp[16];
            float v[16] = {bflo(xa.x), bfhi(xa.x), bflo(xa.y), bfhi(xa.y), bflo(xa.z), bfhi(xa.z), bflo(xa.w), bfhi(xa.w), bflo(xb.x), bfhi(xb.x), bflo(xb.y), bfhi(xb.y), bflo(xb.z), bfhi(xb.z), bflo(xb.w), bfhi(xb.w)};
#pragma unroll
            for (int k = 0; k < 8; ++k) { const u32x4 y = *(const u32x4*)(Yp + rows[k] + (unsigned)((cl >> 8) * 65536 + (cl & 255))); const float w = wk[k];
#pragma unroll
                for (int q = 0; q < 4; ++q) { const f32x2 lo2 = __builtin_amdgcn_cvt_pk_f32_fp8(y[q], false), hi2 = __builtin_amdgcn_cvt_pk_f32_fp8(y[q], true);
                    v[4 * q] += w * lo2[0]; v[4 * q + 1] += w * lo2[1]; v[4 * q + 2] += w * hi2[0]; v[4 * q + 3] += w * hi2[1]; } }
            u32x4 oa, ob;
            oa.x = pk2(v[0], v[1]); oa.y = pk2(v[2], v[3]); oa.z = pk2(v[4], v[5]); oa.w = pk2(v[6], v[7]); ob.x = pk2(v[8], v[9]); ob.y = pk2(v[10], v[11]); ob.z = pk2(v[12], v[13]); ob.w = pk2(v[14], v[15]);
            xo[0] = oa; xo[16] = ob;
#if F8PLE
            { u32x2 o8a, o8b; o8a.x = pk4_f8(v[0], v[1], v[2], v[3]); o8a.y = pk4_f8(v[4], v[5], v[6], v[7]); o8b.x = pk4_f8(v[8], v[9], v[10], v[11]); o8b.y = pk4_f8(v[12], v[13], v[14], v[15]);
              unsigned char* x8 = P.ws + WS_X28 + (size_t)t * DM + a0; *(u32x2*)x8 = o8a; *(u32x2*)(x8 + 128) = o8b; }
#endif
#pragma unroll
            for (int q = 0; q < 16; ++q) ss += v[q] * v[q];
        }
        ss = wave_sum(ss);
        if (lane == 0) rs2[t] = 1.0f / sqrtf(ss * (1.0f / DM) + EPS);
    }
}
DI void gates_tasks(const PArgs& P, int w0, int nw) {
    const int lane = P.lane, fr = lane & 15, fq = lane >> 4;
    const bf16_t* xb = (const bf16_t*)(P.ws + WS_HB); const bf16_t* wg = (const bf16_t*)(P.ws + WS_WIN) + (size_t)5632 * DM; float* gates = (float*)(P.ws + WS_GATES);
    for (int task = w0; task < NTOK / 16; task += nw) {
        const int t0 = task * 16;
        f32x4 acc[2] = {(f32x4){0.f, 0.f, 0.f, 0.f}, (f32x4){0.f, 0.f, 0.f, 0.f}};
        const bf16_t* ap = xb + (size_t)(t0 + fr) * DM + fq * 8; const bf16_t* bp = wg + (size_t)fr * DM + fq * 8;
#pragma unroll 4
        for (int kk = 0; kk < 64; ++kk) {
            const bf16x8 a = *(const bf16x8*)(ap + 32 * kk);
#pragma unroll
            for (int n = 0; n < 2; ++n) { const bf16x8 bb = *(const bf16x8*)(bp + (size_t)(16 * n) * DM + 32 * kk); acc[n] = __builtin_amdgcn_mfma_f32_16x16x32_bf16(a, bb, acc[n], 0, 0, 0); }
        }
#pragma unroll
        for (int n = 0; n < 2; ++n)
#pragma unroll
            for (int j = 0; j < 4; ++j) { const int row = t0 + 4 * fq + j, c = 16 * n + fr; if (c < 24) gates[(size_t)row * 24 + c] = 1.0f / (1.0f + __expf(-acc[n][j])); }
    }
}
constexpr int LDS_MISC = 133120, LDS_BYTES = 135168;
constexpr int NPHASE = 16;
static_assert(LDS_MISC + 1024 == 134144 && LDS_MISC + 1024 + 256 <= LDS_BYTES, "MoBA gate counters live at LDS byte 134144");
#ifndef MK_LAUNCHES
#define MK_LAUNCHES 1
#endif

__global__ void __launch_bounds__(NTHR, 2) mega(Args args) {
    extern __shared__ __attribute__((aligned(16))) unsigned char lds_raw[];
    PArgs P;
    P.out = args.out; P.ws = args.ws; P.lds = (LAS unsigned char*)lds_raw;
    P.tid = threadIdx.x; P.lane = P.tid & 63; P.wave = __builtin_amdgcn_readfirstlane(P.tid >> 6); P.G = gridDim.x; P.wg = blockIdx.x;
    volatile LAS unsigned* MISC = (volatile LAS unsigned*)(P.lds + LDS_MISC);
    LAS int* tab = (LAS int*)(P.lds + LDS_MISC + 64);
    if (P.tid < 16) MISC[P.tid] = 0u;
    __syncthreads();
    unsigned char* ws = P.ws;
    const int vcu = (P.G % 8 == 0) ? (P.wg % 8) * (P.G / 8) + P.wg / 8 : P.wg;
    const int lo = args.ph_lo, hi = args.ph_hi;
    const bool fused = (hi - lo) > 1;
    XcdBarrier bar; bar.bar = (unsigned*)(ws + WS_CTL) + CTLW_BAR; bar.x = 0; bar.st = MISC;
    if (fused) bar = xcd_barrier_post((unsigned*)(ws + WS_CTL) + CTLW_BAR, MISC);
#ifndef PH_MASK
#define PH_MASK 0xFFFF
#endif
#define IN(k) (((PH_MASK >> (k)) & 1) && lo <= (k) && (k) < hi)
#define SEAM(k) do { if (IN(k) && IN((k) + 1)) xcd_barrier(bar); { P.lane = lane_id_v(); P.tid = P.wave * 64 + P.lane; { uintptr_t wsi_ = (uintptr_t)ws, oi_ = (uintptr_t)P.out; asm volatile("" : "+s"(wsi_), "+s"(oi_)); ws = (unsigned char*)(GAS unsigned char*)wsi_; P.out = (float*)(GAS float*)oi_; } P.ws = ws; } } while (0)

#define SEAMX(k, kn) do { if (IN(k) && IN(kn)) xcd_barrier(bar); { P.lane = lane_id_v(); P.tid = P.wave * 64 + P.lane; { uintptr_t wsi_ = (uintptr_t)ws, oi_ = (uintptr_t)P.out; asm volatile("" : "+s"(wsi_), "+s"(oi_)); ws = (unsigned char*)(GAS unsigned char*)wsi_; P.out = (float*)(GAS float*)oi_; } P.ws = ws; } } while (0)

#ifndef REP0
#define REP0 1
#endif
#ifndef REP1
#define REP1 1
#endif
#ifndef REP3
#define REP3 1
#endif
#ifndef REP4
#define REP4 1
#endif
#ifndef REP8
#define REP8 1
#endif
#ifndef REP2
#define REP2 1
#endif
#ifndef REP5
#define REP5 1
#endif
#ifndef REP6
#define REP6 1
#endif
#ifndef REP9
#define REP9 1
#endif
#ifndef STAG_TICKS
#define STAG_TICKS 550
#endif
#ifndef REP40
#define REP40 1
#endif
#ifndef REP50
#define REP50 1
#endif
#ifndef GPROBE
#define GPROBE 0
#endif
#ifndef REP14
#define REP14 1
#endif
#ifndef REP15
#define REP15 1
#endif
#ifndef REP10
#define REP10 1
#endif
#ifndef REP13
#define REP13 1
#endif
    if (IN(0)) { for (int rep = 0; rep < REP0; ++rep) { p0_prologue(P); __syncthreads(); } }
    SEAM(0);
    if (IN(1)) {
        pg8::GridOrder S; S.init(NTOK / 256, 22, P.G, P.wg, ws + WS_WIN, DM);
        pg8::EpiProj E{ws, (const float*)(ws + WS_RS0)};
        pg8::gemm_phase<pg8::EpiProj, pg8::GridOrder, false, true>(P.lds, P.wave, (const bf16_t*)(ws + WS_HB), DM, S, E);
#if REP1 == 3
        pg8::gemm_phase<pg8::EpiProj, pg8::GridOrder, false, true>(P.lds, P.wave, (const bf16_t*)(ws + WS_HB), DM, S, E);
#endif
#if REP1 == 2
        { pg8::EpiNull EN; pg8::gemm_phase<pg8::EpiNull, pg8::GridOrder, false, true, GPROBE>(P.lds, P.wave, (const bf16_t*)(ws + WS_HB), DM, S, EN); }
#endif
    }
    SEAM(1);
    if (IN(2)) { kmean_items(P, P.wg * NWAVES + P.wave, P.G * NWAVES); gates_tasks(P, P.wg * NWAVES + P.wave, P.G * NWAVES); }
    SEAM(2);
    if (IN(3)) {
        { pg8::CmpOrder S{P.G, P.wg, (const char*)(ws + WS_W1K), (const char*)(ws + WS_W1V)};
          pg8::EpiF32 E{(float*)(ws + WS_PK), 256};
          pg8::gemm_phase(P.lds, P.wave, (const bf16_t*)(ws + WS_KC), DM, S, E); }
        __syncthreads();
        LAS unsigned* tk3 = (LAS unsigned*)(P.lds + LDS_MISC + 1536);
        unsigned* q3 = (unsigned*)(ws + WS_CTL) + CTLW_Q3;
        for (;;) {
            if (P.tid == 0) *tk3 = atomicAdd(q3, 1u);
            __syncthreads();
            const unsigned T = *tk3;
            __syncthreads();
            if (T >= 1024u) break;
            att::moba_gate_unit(P, (int)(T >> 8), (int)((T >> 5) & 7u), (int)(T & 31u));
        }
    }
    SEAMX(3, 11);
    if (IN(11)) compress2_items(P);
    SEAMX(11, 4);
    if (IN(4)) {
        {
            const bool sub = (P.G % 32) == 0;
            const bool conv = sub ? (((P.wg >> 3) & 3) == 3) : true;
            const int ncw = sub ? P.G / 4 : P.G, cidx = sub ? ((P.wg >> 5) * 8 + (P.wg & 7)) : P.wg;
            if (conv) { conv_expert_items(P, cidx * NWAVES + P.wave, ncw * NWAVES); __syncthreads(); }
        }
        LAS int* pre = (LAS int*)(P.lds + 114688);
        if (P.wave == 0) {
            const unsigned* lcnt = (const unsigned*)(ws + WS_CTL) + CTLW_LCNT; const int l = P.lane;
            int n[16], tot = 0;
#pragma unroll
            for (int k = 0; k < 16; ++k) { n[k] = ((int)__hip_atomic_load(lcnt + 16 * l + k, __ATOMIC_RELAXED, __HIP_MEMORY_SCOPE_AGENT) + 255) >> 8; tot += n[k]; }
            int inc = tot;
#pragma unroll
            for (int o = 1; o < 64; o <<= 1) { const int v = __shfl_up(inc, o); if (l >= o) inc += v; }
            int run = inc - tot;
#pragma unroll
            for (int k = 0; k < 16; ++k) { pre[16 * l + k] = run; run += n[k]; }
            if (l == 63) pre[1024] = run;
        }
        __syncthreads();
        const int NI = pre[1024];
        const unsigned nt4 = 1024u + (unsigned)((NI + 3) >> 2);
        LAS unsigned* tk = (LAS unsigned*)(P.lds + LDS_MISC + 1536);
        unsigned* q4 = (unsigned*)(ws + WS_CTL) + CTLW_Q4;
        for (;;) {
            if (P.tid == 0) *tk = atomicAdd(q4, 1u);
            __syncthreads();
            const unsigned T = *tk;
            __syncthreads();
            if (T >= nt4) break;
            if (T < 1024u) { const int bg = (int)(T & 7u), c = 127 - (int)(T >> 3); att::nsa_unit(P, bg >> 1, bg & 1, c); }
            else {
                const int i0 = (int)(T - 1024u) * 4;
                for (int i = i0; i < i0 + 4 && i < NI; ++i) {
                    int lo_ = 0, hi_ = 1024;
                    while (hi_ - lo_ > 1) { const int mid = (lo_ + hi_) >> 1; if (pre[mid] <= i) lo_ = mid; else hi_ = mid; }
                    att::moba_item(P, lo_, i - pre[lo_]);
                }
            }
        }
    }
    SEAM(4);
    if (IN(5)) { for (int rep = 0; rep < REP50; ++rep) att::moba_combine(P); for (int rep = 0; rep < REP5; ++rep) outnorm_rows(P); }
    SEAM(5);
    if (IN(6)) {
        pg8::GridOrder S; S.init(NTOK / 256, DM / 256, P.G, P.wg, ws + WS_WOUT, F8G3 ? DM / 2 : DM);
        for (int rep = 0; rep < REP6; ++rep) {
        pg8::EpiOut E{INP(I_X), (bf16_t*)P.out, rep == 0 ? (float*)(ws + WS_CTL + CTL_SSQ1) : (float*)(ws + WS_PK), (unsigned char*)P.out + 128 * MiB};
#if F8G3
        pg8::gemm_phase<pg8::EpiOut, pg8::GridOrder, true>(P.lds, P.wave, (const bf16_t*)(ws + WS_HB8), DM / 2, S, E); }
#else
        pg8::gemm_phase(P.lds, P.wave, (const bf16_t*)(ws + WS_HB), DM, S, E); }
#endif
    }
    SEAM(6);
    if (IN(7)) router_tasks(P);
    SEAM(7);
    if (IN(8)) {
        moe_tables(P, tab);
#if F8GU
        pg8::MoeOrder<true> S{P.G, vcu, tab + 80, tab, __builtin_amdgcn_readfirstlane(tab[80 + 65]) * 4, (const char*)(ws + WS_WGU), (size_t)1024 * DM, (size_t)256 * DM, 0, (const int*)(ws + WS_TOKL), true, tab + 160};
        pg8::EpiGU E{ws + WS_H, (const float*)(ws + WS_RSL), (const float*)(ws + WS_RS1), tab + 160};
        for (int rep = 0; rep < REP8; ++rep) pg8::gemm_phase<pg8::EpiGU, pg8::MoeOrder<true>, true>(P.lds, P.wave, (const bf16_t*)((const unsigned char*)P.out + 128 * MiB), DM / 2, S, E);
#else
        pg8::MoeOrder<true> S{P.G, vcu, tab + 80, tab, __builtin_amdgcn_readfirstlane(tab[80 + 65]) * 4, (const char*)(ws + WS_WGU), (size_t)1024 * DM * 2, (size_t)256 * DM * 2, 0, (const int*)(ws + WS_TOKL), true, tab + 160};
        pg8::EpiGU E{ws + WS_H, (const float*)(ws + WS_RSL), (const float*)(ws + WS_RS1), tab + 160};
        for (int rep = 0; rep < REP8; ++rep) pg8::gemm_phase<pg8::EpiGU, pg8::MoeOrder<true>, false>(P.lds, P.wave, (const bf16_t*)P.out, DM, S, E);
#endif
    }
    SEAM(8);
    if (IN(9)) {
        moe_tables(P, tab);
        pg8::MoeOrder<false, 3> S{P.G, vcu, tab + 80, tab, __builtin_amdgcn_readfirstlane(tab[80 + 65]) * 8, (const char*)(ws + WS_WD), (size_t)DM * DE * (F8DN ? 1 : 2), (size_t)256 * DE * (F8DN ? 1 : 2), 0, nullptr, false, tab + 160};
        for (int rep = 0; rep < REP9; ++rep) {
        pg8::EpiDown E{ws + WS_YP, rep == 0 ? (bf16_t*)P.out : (bf16_t*)nullptr, tab + 160};
        pg8::gemm_phase<pg8::EpiDown, pg8::MoeOrder<false, 3>, (F8DN != 0)>(P.lds, P.wave, (const bf16_t*)(ws + WS_H), F8DN ? DE / 2 : DE, S, E); }
    }
    SEAM(9);
    if (IN(10)) {
        moe_tables(P, tab);
        const bool sub = (P.G % 32) == 0;
        const bool ppw = sub && (((P.wg >> 3) & 3) == 3);
        if (!sub) { combine_rows(P, tab, 1.0f / YP_SCALE, P.wg * NWAVES + P.wave, P.G * NWAVES);
                    pg8::GridOrder S; S.init(NTOK / 256, DM / 256, P.G, P.wg, ws + WS_WPLE, PLE); pg8::EpiBf16 E{(bf16_t*)(ws + WS_PP), DM};
                    pg8::gemm_phase(P.lds, P.wave, (const bf16_t*)(ws + WS_PB), PLE, S, E); }
        else if (ppw) { pg8::GridOrder S; S.init(NTOK / 256, DM / 256, P.G / 4, (P.wg >> 5) * 8 + (P.wg & 7), ws + WS_WPLE, PLE); pg8::EpiBf16 E{(bf16_t*)(ws + WS_PP), DM};
                        pg8::gemm_phase(P.lds, P.wave, (const bf16_t*)(ws + WS_PB), PLE, S, E); }
        else { const int ci = (P.wg >> 5) * 24 + ((P.wg >> 3) & 3) * 8 + (P.wg & 7);
               combine_rows(P, tab, 1.0f / YP_SCALE, ci * NWAVES + P.wave, (P.G / 4) * 3 * NWAVES); }
    }
    SEAMX(10, 14);
    if (IN(14)) {
        pg8::RowOrder S{(NTOK / 256) * 8, P.G, vcu, (const char*)(ws + WS_WPG), (size_t)256 * DM * (F8PLE ? 1 : 2)};
        pg8::EpiPleFin E{(const bf16_t*)(ws + WS_X2B), P.out, (const bf16_t*)(ws + WS_PP), (const float*)(ws + WS_RS2), (float*)(ws + WS_CTL + CTL_SSQ3), (unsigned*)(ws + WS_CTL) + CTLW_ARR, INP(I_NFING)};
#if F8PLE
        pg8::gemm_phase<pg8::EpiPleFin, pg8::RowOrder, true>(P.lds, P.wave, (const bf16_t*)(ws + WS_X28), DM / 2, S, E);
#else
        pg8::gemm_phase<pg8::EpiPleFin, pg8::RowOrder, false>(P.lds, P.wave, (const bf16_t*)(ws + WS_X2B), DM, S, E);
#endif
    }
#undef IN
#undef SEAM
}

extern "C" void kernel_launch(void* const* d_in, const int* in_sizes, int n_in, void* d_out, int out_size, void* d_ws, size_t ws_size, hipStream_t stream) {
    static int grid = 0;
    if (grid == 0) {
        if (n_in != 26 || in_sizes[0] != NTOK * DM || out_size != NTOK * DM || ws_size < WS_END) {
            fprintf(stderr, "kernel_launch: unexpected shapes (n_in %d, in0 %d, out %d, ws %zu < %zu); nothing launched\n", n_in, n_in > 0 ? in_sizes[0] : -1, out_size, ws_size, (size_t)WS_END); grid = -1; return; }
        int dev = 0, cus = 0, per_cu = 0;
        if (hipGetDevice(&dev) != hipSuccess || hipDeviceGetAttribute(&cus, hipDeviceAttributeMultiprocessorCount, dev) != hipSuccess) { grid = -1; return; }
        if (hipFuncSetAttribute((const void*)mega, hipFuncAttributeMaxDynamicSharedMemorySize, LDS_BYTES) != hipSuccess) { fprintf(stderr, "kernel_launch: hipFuncSetAttribute failed\n"); grid = -1; return; }
        if (hipOccupancyMaxActiveBlocksPerMultiprocessor(&per_cu, (const void*)mega, NTHR, LDS_BYTES) != hipSuccess || per_cu < 1) { fprintf(stderr, "kernel_launch: occupancy query says %d\n", per_cu); }
        (void)hipGetLastError();
        grid = cus & ~7;
        if (grid < 8) { fprintf(stderr, "kernel_launch: %d CUs\n", cus); grid = -1; return; }
    }
    if (grid < 0) return;
    (void)hipMemsetAsync((char*)d_ws + WS_CTL, 0, CTL_BYTES, stream);
    Args a{};
    for (int i = 0; i < 26; ++i) a.in[i] = (const float*)d_in[i];
    a.out = (float*)d_out; a.ws = (unsigned char*)d_ws;
#if MK_LAUNCHES == 1
    a.ph_lo = 0; a.ph_hi = NPHASE;
    hipLaunchKernelGGL(mega, dim3(grid), dim3(NTHR), LDS_BYTES, stream, a);
#else
    for (int k = 0; k < NPHASE; ++k) { a.ph_lo = k; a.ph_hi = k + 1; hipLaunchKernelGGL(mega, dim3(grid), dim3(NTHR), LDS_BYTES, stream, a); }
#endif
    const hipError_t le = hipPeekAtLastError();
    if (le != hipSuccess) fprintf(stderr, "kernel_launch: launch failed: %s\n", hipGetErrorName(le));
}
```

```cpp
#include <hip/hip_runtime.h>
#include <cstdio>
#include <cstdint>

#define DI __device__ __forceinline__
#define GAS __attribute__((address_space(1)))
#define LAS __attribute__((address_space(3)))
typedef unsigned short bf16_t;
typedef short bf16x8 __attribute__((ext_vector_type(8)));
typedef short s16x4 __attribute__((ext_vector_type(4)));
typedef float f32x2 __attribute__((ext_vector_type(2)));
typedef float f32x4 __attribute__((ext_vector_type(4)));
typedef float f32x16 __attribute__((ext_vector_type(16)));
typedef unsigned u32x2 __attribute__((ext_vector_type(2)));
typedef unsigned u32x4 __attribute__((ext_vector_type(4)));
typedef __bf16 bf2_t __attribute__((ext_vector_type(2)));
typedef int v8i32 __attribute__((ext_vector_type(8)));
#ifndef F8GU
#define F8GU 1
#endif
#ifndef F8DN
#define F8DN 1
#endif
#ifndef F8G3
#define F8G3 0
#endif
#ifndef F8PLE
#define F8PLE 1
#endif
constexpr float WOUT_SCALE = F8G3 ? 64.f : 1.f, WPG_SCALE = F8PLE ? 64.f : 1.f;
constexpr float YP_SCALE = 16.f;
constexpr float WGU_SCALE = F8GU ? 64.f : 1.f, WD_SCALE = F8DN ? 32.f : 1.f;

constexpr int NB = 4, NT = 8192, DM = 2048, NTOK = NB * NT, HD = 128;
constexpr int DIN = 5656, DINP = 5888;
constexpr int NE = 64, DE = 512, PLE = 256;
constexpr float EPS = 1e-6f;
constexpr float LOG2E = 1.4426950408889634f;
constexpr float QSCALE = 0.08838834764831845f * LOG2E;
constexpr int NWAVES = 8, NTHR = 512;
constexpr int PSH = 278528;
constexpr int HROWS = PSH + NTOK;

constexpr size_t MiB = 1u << 20;
constexpr size_t WS_CTL = 0, CTL_BYTES = MiB + 262144;
constexpr size_t CTLW_BAR = 4096;
constexpr size_t CTLW_CNT = 16384;
constexpr size_t CTL_SSQ1 = 1 * MiB, CTL_SSQ3 = CTL_SSQ1 + 131072;
constexpr size_t WS_RS0 = 4 * MiB, WS_RS1 = WS_RS0 + 131072, WS_RS2 = WS_RS1 + 131072, WS_KMEAN = WS_RS2 + 131072  , WS_BIAS = WS_KMEAN + 262144  ;
constexpr size_t WS_KCMP = 5 * MiB, WS_VCMP = 6 * MiB;
constexpr size_t WS_GATES = 7 * MiB;
constexpr size_t WS_ASG = 10 * MiB;
constexpr size_t WS_PK = 12 * MiB, WS_PV = 16 * MiB;
constexpr size_t WS_TOKL = 20 * MiB, WS_WL = 28 * MiB, WS_RSL = 36 * MiB;
constexpr size_t WS_PB = 44 * MiB;
constexpr size_t WS_WPG = 60 * MiB, WS_WPLE = 68 * MiB, WS_WR = 69 * MiB, WS_W1K = 70 * MiB, WS_W1V = 71 * MiB;
constexpr size_t WS_WD = 72 * MiB;
constexpr size_t WS_WGU = 202 * MiB;
constexpr size_t WS_WIN = 462 * MiB;
constexpr size_t WS_WOUT = 485 * MiB;
constexpr size_t WS_HB = 493 * MiB;
constexpr size_t WS_PROJ = 621 * MiB;
constexpr size_t WS_MQ = WS_PROJ, WS_MK = WS_MQ + 64 * MiB, WS_MV = WS_MK + 64 * MiB, WS_NQ = WS_MV + 64 * MiB;
constexpr size_t WS_KC = WS_NQ + 64 * MiB, WS_VC = WS_KC + 16 * MiB, WS_KS = WS_VC + 16 * MiB, WS_VS = WS_KS + 16 * MiB, WS_KW = WS_VS + 16 * MiB, WS_VW = WS_KW + 16 * MiB;
constexpr size_t WS_H = WS_PROJ + 128 * MiB;
constexpr size_t WS_HB8 = WS_PROJ;
constexpr size_t WS_YP = WS_WGU;
constexpr size_t WS_X2B = WS_H;
constexpr size_t WS_X28 = WS_H + 128 * MiB;
constexpr size_t WS_PP = WS_H + 192 * MiB;
static_assert(F8DN == 1, "the workspace map below assumes e4m3 H (152 MiB)");
constexpr size_t WS_ML = 1054 * MiB;
constexpr size_t WS_LIST = 1062 * MiB;
constexpr size_t CTLW_Q3 = 28704;
constexpr size_t CTLW_Q4 = 28672;
constexpr size_t CTLW_ARR = 24576;
constexpr size_t CTLW_LCNT = 20480;
constexpr size_t WS_END = 1094 * MiB;
static_assert(WS_YP + (size_t)PSH * 2048 <= WS_H, "Yp must end below H");
static_assert(WS_H + (size_t)HROWS * 512 <= WS_X2B + 0 * MiB + 152 * MiB && WS_X28 + 64 * MiB <= WS_PP && WS_PP + 128 * MiB <= WS_END, "PP placement");
static_assert(WS_VW + 16 * MiB <= WS_END && WS_H + (size_t)HROWS * 1024 <= WS_ML && WS_END <= 1100 * MiB, "ws map");

DI unsigned pk4_f8(float a, float b, float c, float d) { unsigned w = 0u; w = __builtin_amdgcn_cvt_pk_fp8_f32(a, b, w, false); w = __builtin_amdgcn_cvt_pk_fp8_f32(c, d, w, true); return w; }
DI unsigned pk2(float lo, float hi) { f32x2 v = {lo, hi}; return __builtin_bit_cast(unsigned, __builtin_convertvector(v, bf2_t)); }
DI float bflo(unsigned u) { return __uint_as_float(u << 16); }
DI float bfhi(unsigned u) { return __uint_as_float(u & 0xffff0000u); }
DI float wave_sum(float v) {
#pragma unroll
    for (int o = 1; o < 64; o <<= 1) v += __shfl_xor(v, o);
    return v;
}
DI int lane_id_v() { int l; asm volatile("v_mbcnt_lo_u32_b32 %0, -1, 0\n\tv_mbcnt_hi_u32_b32 %0, -1, %0" : "=v"(l)); return l; }
#define LDS_WAIT() asm volatile("s_waitcnt lgkmcnt(0)" ::: "memory")
#define VM_WAIT() asm volatile("s_waitcnt vmcnt(0)" ::: "memory")

#define XB_TMO      128
#define XB_XCNT(j)  (256  + 64 * (j))
#define XB_XSUB(j)  (1280 + 64 * (j))
#define XB_XGEN(j)  (2304 + 64 * (j))
#define XB_TOP      3328
#define XB_TOPGEN   3392
#define XCD_BAR_WORDS 3456
#define XB_SPIN_CAP (1u << 18)
DI unsigned xb_ld(unsigned* p)              { return __hip_atomic_load(p, __ATOMIC_RELAXED, __HIP_MEMORY_SCOPE_AGENT); }
DI unsigned xb_add(unsigned* p, unsigned v) { return __hip_atomic_fetch_add(p, v, __ATOMIC_RELAXED, __HIP_MEMORY_SCOPE_AGENT); }
DI unsigned xb_xcc_id() { return (unsigned)__builtin_amdgcn_s_getreg((3 << 11) | 20) & 0xFu; }
#define XB_SPIN(cond, bar) do { unsigned _sp = 0; while (cond) { __builtin_amdgcn_s_sleep(1); \
    if ((++_sp & 255u) == 0u) { if (xb_ld(&(bar)[XB_TMO])) break; if (_sp > XB_SPIN_CAP) { atomicAdd(&(bar)[XB_TMO], 1u); break; } } } } while (0)
struct XcdBarrier { unsigned* bar; unsigned x; volatile LAS unsigned* st; };
DI XcdBarrier xcd_barrier_post(unsigned* bar, volatile LAS unsigned* st) {
    XcdBarrier b; b.bar = bar; b.x = xb_xcc_id(); b.st = st;
    if (threadIdx.x == 0) (void)xb_add(&bar[XB_XCNT(b.x)], 1u);
    return b;
}
DI void xcd_barrier_complete(unsigned* bar, unsigned x, unsigned& nloc, unsigned& nx) {
    const unsigned G = gridDim.x * gridDim.y * gridDim.z;
    unsigned sum, cnt, mine, sp = 0u;
    for (;;) {
        sum = 0u; cnt = 0u; mine = 0u;
#pragma unroll
        for (unsigned j = 0; j < 16; ++j) { const unsigned c = xb_ld(&bar[XB_XCNT(j)]); sum += c; cnt += (c > 0u) ? 1u : 0u; mine = (j == x) ? c : mine; }
        if (sum == G) break;
        __builtin_amdgcn_s_sleep(1);
        if ((++sp & 255u) == 0u) { if (xb_ld(&bar[XB_TMO])) break; if (sp > XB_SPIN_CAP) { atomicAdd(&bar[XB_TMO], 1u); break; } }
    }
    nloc = mine > 0u ? mine : 1u; nx = cnt > 0u ? cnt : 1u;
}
DI void xcd_barrier(const XcdBarrier& b) {
    asm volatile("s_waitcnt vmcnt(0)" ::: "memory");
    __syncthreads();
    if (threadIdx.x == 0) {
        unsigned* bar = b.bar;
        __builtin_amdgcn_s_waitcnt(0);
        unsigned nloc = b.st[0], nx = b.st[1];
        if (nloc == 0u) { xcd_barrier_complete(bar, b.x, nloc, nx); b.st[0] = nloc; b.st[1] = nx; }
        const unsigned old = xb_add(&bar[XB_XSUB(b.x)], 1u);
        const unsigned gen = old / nloc;
        if (old + 1u == (gen + 1u) * nloc) {
            __builtin_amdgcn_fence(__ATOMIC_RELEASE, "agent");
            asm volatile("s_waitcnt vmcnt(0)" ::: "memory");
            const unsigned og = xb_add(&bar[XB_TOP], 1u);
            const unsigned tg = og / nx;
            if (og + 1u == (tg + 1u) * nx) xb_add(&bar[XB_TOPGEN], 1u);
            else XB_SPIN(xb_ld(&bar[XB_TOPGEN]) == tg, bar);
            __builtin_amdgcn_fence(__ATOMIC_ACQUIRE, "agent");
            xb_add(&bar[XB_XGEN(b.x)], 1u);
            asm volatile("s_waitcnt vmcnt(0)" ::: "memory");
        } else {
            XB_SPIN(xb_ld(&bar[XB_XGEN(b.x)]) == gen, bar);
            __builtin_amdgcn_fence(__ATOMIC_ACQUIRE, "agent");
            asm volatile("s_waitcnt vmcnt(0)" ::: "memory");
        }
    }
    __syncthreads();
}

struct Args {
    const float* in[26];
    float* out; unsigned char* ws;
    int ph_lo, ph_hi;
};
enum { I_X = 0, I_P, I_NMIXG, I_WIN, I_MOBAG, I_NSAG, I_POSK, I_W1K, I_W2K, I_POSV, I_W1V, I_W2V, I_WOUT, I_NFFNG, I_WROUTER, I_RBIAS,
       I_WGE, I_WUE, I_WDE, I_WGS, I_WUS, I_WDS, I_NPLEG, I_WPLE, I_WPLEG, I_NFING };
DI void tr64(const float* src, int ldw, int nvalid, const float* gain, bf16_t* dst, int ldd, LAS float* scr, int lane) {
    const int c4 = (lane & 15) * 4, r0 = lane >> 4;
#pragma unroll 8
    for (int i = 0; i < 16; ++i) {
        const int kk = 4 * i + r0;
        f32x4 v = {0.f, 0.f, 0.f, 0.f};
        if (c4 < nvalid) v = *(const f32x4*)(src + (size_t)kk * ldw + c4);
        if (gain) { const float g = gain[kk]; v = v * g; }
        LAS float* s = scr + kk * 65 + c4;
        s[0] = v.x; s[1] = v.y; s[2] = v.z; s[3] = v.w;
    }
    LDS_WAIT();
    const int c = lane & 7, nr = lane >> 3;
#pragma unroll
    for (int j = 0; j < 8; ++j) {
        const int n = nr + 8 * j;
        const LAS float* s = scr + (8 * c) * 65 + n;
        u32x4 o; o.x = pk2(s[0 * 65], s[1 * 65]); o.y = pk2(s[2 * 65], s[3 * 65]); o.z = pk2(s[4 * 65], s[5 * 65]); o.w = pk2(s[6 * 65], s[7 * 65]);
        *(u32x4*)(dst + (size_t)n * ldd + 8 * c) = o;
    }
    LDS_WAIT();
}

DI void tr64_f8(const float* src, int ldw, const float* gain, float scale, unsigned char* dst, int ldd, LAS float* scr, int lane) {
    const int c4 = (lane & 15) * 4, r0 = lane >> 4;
#pragma unroll 8
    for (int i = 0; i < 16; ++i) {
        const int kk = 4 * i + r0;
        f32x4 v = *(const f32x4*)(src + (size_t)kk * ldw + c4);
        const float g = gain ? gain[kk] * scale : scale; v = v * g;
        LAS float* s = scr + kk * 65 + c4;
        s[0] = v.x; s[1] = v.y; s[2] = v.z; s[3] = v.w;
    }
    LDS_WAIT();
    const int c = lane & 7, nr = lane >> 3;
#pragma unroll
    for (int j = 0; j < 8; ++j) {
        const int n = nr + 8 * j;
        const LAS float* s = scr + (8 * c) * 65 + n;
        unsigned w0 = 0u, w1 = 0u;
        w0 = __builtin_amdgcn_cvt_pk_fp8_f32(s[0 * 65], s[1 * 65], w0, false); w0 = __builtin_amdgcn_cvt_pk_fp8_f32(s[2 * 65], s[3 * 65], w0, true);
        w1 = __builtin_amdgcn_cvt_pk_fp8_f32(s[4 * 65], s[5 * 65], w1, false); w1 = __builtin_amdgcn_cvt_pk_fp8_f32(s[6 * 65], s[7 * 65], w1, true);
        u32x2 o; o.x = w0; o.y = w1;
        *(u32x2*)(dst + (size_t)n * ldd + 8 * c) = o;
    }
    LDS_WAIT();
}

struct PArgs {
    float* out; unsigned char* ws;
    LAS unsigned char* lds; int tid, lane, wave, G, wg;
};
DI const float* INP(int i) {
    typedef __attribute__((address_space(4))) const char* kptr_t;
    kptr_t ka = (kptr_t)__builtin_amdgcn_kernarg_segment_ptr();
    asm volatile("" : "+s"(ka));
    const uintptr_t raw = *(__attribute__((address_space(4))) const uintptr_t*)(ka + 8 * i);
    const GAS float* g = (const GAS float*)raw;
    return (const float*)g;
}

struct TrItem { const float* src; int ldw; const float* gain; float scale; unsigned char* dst; int ldd; bool bf; };
DI void tr_expert_desc(const PArgs& P, int r, TrItem& d) {
    constexpr int I_EG = 65 * 256, I_EU = 65 * 256;
    unsigned char* ws = P.ws;
    d.bf = false;
    if (r < I_EG + I_EU) { const int up = r >= I_EG; if (up) r -= I_EG; const int e = r >> 8, q = r & 255, kb = q >> 3, nb = q & 7;
        const float* w = (e < 64) ? INP(up ? I_WUE : I_WGE) + (size_t)e * DM * DE : INP(up ? I_WUS : I_WGS);
        const int n0 = 64 * nb, drow = (n0 >> 7) * 256 + up * 128 + (n0 & 127);
        d.src = w + (size_t)(64 * kb) * DE + n0; d.ldw = DE; d.gain = INP(I_NFFNG) + 64 * kb; d.scale = WGU_SCALE; d.dst = ws + WS_WGU + ((size_t)e * 1024 + drow) * DM + 64 * kb; d.ldd = DM; return; }
    r -= I_EG + I_EU;
    { const int e = r >> 8, q = r & 255, kb = q >> 5, nb = q & 31;
        const float* w = (e < 64) ? INP(I_WDE) + (size_t)e * DE * DM : INP(I_WDS);
        if (e < 65) { d.src = w + (size_t)(64 * kb) * DM + 64 * nb; d.ldw = DM; d.gain = nullptr; d.scale = WD_SCALE; d.dst = ws + WS_WD + ((size_t)e * DM + 64 * nb) * DE + 64 * kb; d.ldd = DE; return; } }
    r -= 65 * 256;
    if (r < 1024) { const int kb = r >> 5, nb = r & 31; d.src = INP(I_WOUT) + (size_t)(64 * kb) * DM + 64 * nb; d.ldw = DM; d.gain = (kb < 16) ? INP(I_MOBAG) + 64 * kb : INP(I_NSAG) + 64 * (kb - 16);
        d.scale = 1.0f; d.dst = ws + WS_WOUT + ((size_t)(64 * nb) * DM + 64 * kb) * 2; d.ldd = DM; d.bf = true; return; }
    r -= 1024;
    if (r < 1024) { const int kb = r >> 5, nb = r & 31; d.src = INP(I_WPLEG) + (size_t)(64 * kb) * DM + 64 * nb; d.ldw = DM; d.gain = INP(I_NPLEG) + 64 * kb;
        d.scale = WPG_SCALE; d.dst = ws + WS_WPG + (size_t)(64 * nb) * DM + 64 * kb; d.ldd = DM; return; }
    r -= 1024;
    { const int kb = r >> 5, nb = r & 31; d.src = INP(I_WPLE) + (size_t)(64 * kb) * DM + 64 * nb; d.ldw = DM; d.gain = nullptr;
        d.scale = 1.0f; d.dst = ws + WS_WPLE + ((size_t)(64 * nb) * PLE + 64 * kb) * 2; d.ldd = PLE; d.bf = true; }
}
DI void tr_load(const TrItem& d, f32x4 (&v)[16], float (&g)[16], int lane) {
    const int c4 = (lane & 15) * 4, r0 = lane >> 4;
#pragma unroll
    for (int i = 0; i < 16; ++i) { const int kk = 4 * i + r0; v[i] = *(const f32x4*)(d.src + (size_t)kk * d.ldw + c4); g[i] = d.gain ? d.gain[kk] : 1.0f; }
}
DI void tr_finish_f8(const TrItem& d, const f32x4 (&v)[16], const float (&g)[16], LAS float* scr, int lane) {
    const int c4 = (lane & 15) * 4, r0 = lane >> 4;
#pragma unroll
    for (int i = 0; i < 16; ++i) { const int kk = 4 * i + r0; const f32x4 w = v[i] * (g[i] * d.scale); LAS float* s = scr + kk * 65 + c4; s[0] = w.x; s[1] = w.y; s[2] = w.z; s[3] = w.w; }
    LDS_WAIT();
    const int c = lane & 7, nr = lane >> 3;
#pragma unroll
    for (int j = 0; j < 8; ++j) {
        const int n = nr + 8 * j;
        const LAS float* s = scr + (8 * c) * 65 + n;
        if (d.bf) { u32x4 o; o.x = pk2(s[0 * 65], s[1 * 65]); o.y = pk2(s[2 * 65], s[3 * 65]); o.z = pk2(s[4 * 65], s[5 * 65]); o.w = pk2(s[6 * 65], s[7 * 65]);
            *(u32x4*)(d.dst + ((size_t)n * d.ldd + 8 * c) * 2) = o; }
        else { u32x2 o; o.x = pk4_f8(s[0 * 65], s[1 * 65], s[2 * 65], s[3 * 65]); o.y = pk4_f8(s[4 * 65], s[5 * 65], s[6 * 65], s[7 * 65]);
            *(u32x2*)(d.dst + (size_t)n * d.ldd + 8 * c) = o; }
    }
    LDS_WAIT();
}
DI void conv_expert_items(const PArgs& P, int w0, int nw) {
    static_assert(F8GU == 1 && F8DN == 1, "e4m3 expert weights");
    LAS float* scr = (LAS float*)(P.lds + P.wave * 16640);
    const int lane = P.lane;
    static_assert(F8G3 == 0 && F8PLE == 1, "formats of the late weights");
    constexpr int NIT = 3 * 65 * 256 + 1024 + 1024 + 128;
    if (w0 >= NIT) return;
    TrItem dA, dB; f32x4 vA[16], vB[16]; float gA[16], gB[16];
    tr_expert_desc(P, w0, dA); tr_load(dA, vA, gA, lane);
    for (int it = w0; it < NIT; it += 2 * nw) {
        const bool h1 = it + nw < NIT;
        if (h1) { tr_expert_desc(P, it + nw, dB); tr_load(dB, vB, gB, lane); }
        tr_finish_f8(dA, vA, gA, scr, lane);
        const bool h2 = it + 2 * nw < NIT;
        if (h2) { tr_expert_desc(P, it + 2 * nw, dA); tr_load(dA, vA, gA, lane); }
        if (h1) tr_finish_f8(dB, vB, gB, scr, lane);
    }
    { const f32x4* p = (const f32x4*)INP(I_P); u32x2* pb = (u32x2*)(P.ws + WS_PB);
      const int n4 = NTOK * PLE / 4;
      for (int i = w0 * 64 + lane; i < n4; i += nw * 64) { const f32x4 v = p[i]; u32x2 w; w.x = pk2(v.x, v.y); w.y = pk2(v.z, v.w); pb[i] = w; } }
}

DI void p0_prologue(const PArgs& P) {
    LAS float* scr = (LAS float*)(P.lds + P.wave * 16640);
    const int gw = P.wg * NWAVES + P.wave, NGW = P.G * NWAVES, lane = P.lane;
    unsigned char* ws = P.ws;
    constexpr int I_IN = 32 * 92, I_OUT = 32 * 32, I_PG = 32 * 32, I_PLE_ = 4 * 32, I_R = 32, I_W1 = 4 * 64, I_EG = 65 * 256, I_EU = 65 * 256, I_ED = 65 * 256;
    constexpr int NITEMS = I_IN + I_R + I_W1;
    for (int it = gw; it < NITEMS; it += NGW) {
        int r = it;
        if (r < I_IN) { const int kb = r / 92, nb = r % 92; tr64(INP(I_WIN) + (size_t)(64 * kb) * DIN + 64 * nb, DIN, DIN - 64 * nb, INP(I_NMIXG) + 64 * kb, (bf16_t*)(ws + WS_WIN) + (size_t)(64 * nb) * DM + 64 * kb, DM, scr, lane); continue; } r -= I_IN;
        if (r < I_R) { const int kb = r; tr64(INP(I_WROUTER) + (size_t)(64 * kb) * NE, NE, 64, INP(I_NFFNG) + 64 * kb, (bf16_t*)(ws + WS_WR) + 64 * kb, DM, scr, lane); continue; } r -= I_R;
        if (r < I_W1) { const int kv = r >> 7, q = r & 127, slab = q >> 6, kb = (q >> 1) & 31, nb = q & 1;
            const float* w1 = INP(kv ? I_W1V : I_W1K);
            tr64(w1 + (size_t)(slab * 2048 + 64 * kb) * HD + 64 * nb, HD, 64, nullptr, (bf16_t*)(ws + (kv ? WS_W1V : WS_W1K)) + (size_t)(slab * 128 + 64 * nb) * DM + 64 * kb, DM, scr, lane); continue; } r -= I_W1;
    }
    if (gw < NTOK) {
        const float* x = INP(I_X); bf16_t* xb = (bf16_t*)(ws + WS_HB);
        f32x4 v[8];
        { const f32x4* xr = (const f32x4*)(x + (size_t)gw * DM) + lane;
#pragma unroll
          for (int j = 0; j < 8; ++j) v[j] = xr[64 * j]; }
        for (int row = gw; row < NTOK; row += NGW) {
            const int nrow = (row + NGW < NTOK) ? row + NGW : row;
            f32x4 vn[8];
            { const f32x4* xr = (const f32x4*)(x + (size_t)nrow * DM) + lane;
#pragma unroll
              for (int j = 0; j < 8; ++j) vn[j] = xr[64 * j]; }
            float s = 0.f;
#pragma unroll
            for (int j = 0; j < 8; ++j) s += (v[j].x * v[j].x + v[j].y * v[j].y) + (v[j].z * v[j].z + v[j].w * v[j].w);
            s = wave_sum(s);
            const float rs = 1.0f / sqrtf(s * (1.0f / DM) + EPS);
            u32x2* o = (u32x2*)(xb + (size_t)row * DM) + lane;
#pragma unroll
            for (int j = 0; j < 8; ++j) { u32x2 w; w.x = pk2(v[j].x * rs, v[j].y * rs); w.y = pk2(v[j].z * rs, v[j].w * rs); o[64 * j] = w; }
#pragma unroll
            for (int j = 0; j < 8; ++j) v[j] = vn[j];
        }
    }
    if (gw < 256) {
        const int kv = gw >> 7, n = gw & 127;
        const float* pos = INP(kv ? I_POSV : I_POSK); const float* w1 = INP(kv ? I_W1V : I_W1K);
        float s = 0.f;
        for (int k = lane; k < 4096; k += 64) s += pos[k] * w1[(size_t)k * HD + n];
        s = wave_sum(s);
        if (lane == 0) ((float*)(ws + WS_BIAS))[gw] = s;
    }
}

namespace pg8 {
constexpr int BM = 256, BK = 64, HALF = 128, HTB = HALF * BK * 2, STAGE_BYTES = 8 * HTB;
DI int lds_byte(int r, int c) { const int st = (r >> 4) * 2 + (c >> 5), rr = r & 15, cc = c & 31, ob = rr * 64 + cc * 2; return st * 1024 + (ob ^ (((ob >> 9) & 1) << 5)); }
DI void stage_rc(int b, int& R, int& C) { const int st = b / 1024, sb = b % 1024, swz = sb ^ (((sb >> 9) & 1) << 5); R = (st >> 1) * 16 + swz / 64; C = (st & 1) * 32 + (swz % 64) / 2; }
DI int perm32(int rho) { const int n = rho >> 4, i = rho & 15; return 8 * (i >> 2) + 4 * n + (i & 3); }

struct Unit { const char* B; int arow0; const int* tok; int nvalid; int pm, pn, e; };

template <class Epi, class Sched, bool FP8 = false, bool CM64 = false, int PROBE = 0>
DI void gemm_phase(LAS unsigned char* lds, int wid, const bf16_t* Abase, int K, const Sched& S, const Epi& E) {
    const int lane = lane_id_v(), tid = wid * 64 + lane, wr = wid >> 2, wc = wid & 3, fr = lane & 15, fq = lane >> 4;
    asm volatile("" : "+s"(K));
    const int nt = K / BK;
    unsigned voffB[2];
#pragma unroll
    for (int i = 0; i < 2; ++i) { int R, C; stage_rc(tid * 16 + i * 8192, R, C); const int Rb = (CM64 ? (R >> 5) * 64 : (R & ~31)) + perm32(R & 31); voffB[i] = (unsigned)(Rb * K + C) * 2u; }
    const size_t kstep = (size_t)(BK * 2);
    const size_t hstepB = (size_t)(CM64 ? 32 : HALF) * K * 2;
    const unsigned ldsw = (unsigned)wid * 1024u;
    const int aoff = FP8 ? lds_byte(wr * 64 + fr, (fq & 1) * 16) + (fq >> 1) * 1024 : lds_byte(wr * 64 + fr, fq * 8);
    const int boff = FP8 ? lds_byte(wc * 32 + fr, (fq & 1) * 16) + (fq >> 1) * 1024 : lds_byte(wc * 32 + fr, fq * 8);
#define PG8_SA(b, h) (((b) * 2 + (h)) * HTB)
#define PG8_SB(b, h) ((4 + (b) * 2 + (h)) * HTB)
#define PG8_STAGEB(bufoff, gbase) do { unsigned _b0 = voffB[0], _b1 = voffB[1]; const char* _bk = (const char*)(gbase); unsigned _lw = ldsw; asm volatile("" : "+v"(_b0), "+v"(_b1), "+s"(_bk), "+s"(_lw));     \
        __builtin_amdgcn_global_load_lds((const unsigned*)(_bk + _b0), (LAS unsigned*)(lds + (bufoff) + _lw), 16, 0, 0); \
        __builtin_amdgcn_global_load_lds((const unsigned*)(_bk + _b1), (LAS unsigned*)(lds + (bufoff) + _lw + 8192), 16, 0, 0); } while (0)
#define PG8_STAGEA(bufoff, kb, o0, o1) do { const char* _ak = (const char*)Abase + (kb); unsigned _o0 = (o0), _o1 = (o1), _lw = ldsw; \
        asm volatile("" : "+v"(_o0), "+v"(_o1), "+s"(_ak), "+s"(_lw));     \
        __builtin_amdgcn_global_load_lds((const unsigned*)(_ak + _o0), (LAS unsigned*)(lds + (bufoff) + _lw), 16, 0, 0); \
        __builtin_amdgcn_global_load_lds((const unsigned*)(_ak + _o1), (LAS unsigned*)(lds + (bufoff) + _lw + 8192), 16, 0, 0); } while (0)
#define PG8_RD16(off) (*(const LAS u32x4*)(lds + (off)))
#define PG8_LDA(dst, b, h) do { if (PROBE == 2) break; _Pragma("unroll") for (int m = 0; m < 4; ++m) { \
        if constexpr (FP8) { const u32x4 _p = *(const LAS u32x4*)(abase8 + (PG8_SA(b, h) + m * 2048)), _q = *(const LAS u32x4*)(abase8 + (PG8_SA(b, h) + m * 2048 + 16)); \
            dst##8[m] = (v8i32){(int)_p.x, (int)_p.y, (int)_p.z, (int)_p.w, (int)_q.x, (int)_q.y, (int)_q.z, (int)_q.w}; } \
        else { _Pragma("unroll") for (int k = 0; k < 2; ++k) dst[m][k] = *(const LAS bf16x8*)(lds + PG8_SA(b, h) + aoff + m * 2048 + k * 1024); } } } while (0)
#define PG8_LDB(dst, b, h) do { if (PROBE == 1) break; _Pragma("unroll") for (int n = 0; n < 2; ++n) { \
        if constexpr (FP8) { const u32x4 _p = *(const LAS u32x4*)(bbase8 + (PG8_SB(b, h) - 65536 + n * 2048)), _q = *(const LAS u32x4*)(bbase8 + (PG8_SB(b, h) - 65536 + n * 2048 + 16)); \
            dst##8[n] = (v8i32){(int)_p.x, (int)_p.y, (int)_p.z, (int)_p.w, (int)_q.x, (int)_q.y, (int)_q.z, (int)_q.w}; } \
        else { _Pragma("unroll") for (int k = 0; k < 2; ++k) dst[n][k] = *(const LAS bf16x8*)(lds + PG8_SB(b, h) + boff + n * 2048 + k * 1024); } } } while (0)
#define PG8_MMA(ai, bj, At, Bt) do { if (PROBE == 3) break; __builtin_amdgcn_s_setprio(1); \
        if constexpr (FP8) { _Pragma("unroll") for (int m = 0; m < 4; ++m) _Pragma("unroll") for (int n = 0; n < 2; ++n) \
            acc[ai][bj][m][n] = __builtin_amdgcn_mfma_scale_f32_16x16x128_f8f6f4(Bt##8[n], At##8[m], acc[ai][bj][m][n], 0, 0, 0, 127, 0, 127);     } \
        else { _Pragma("unroll") for (int m = 0; m < 4; ++m) _Pragma("unroll") for (int n = 0; n < 2; ++n) _Pragma("unroll") for (int k = 0; k < 2; ++k) \
            acc[ai][bj][m][n] = __builtin_amdgcn_mfma_f32_16x16x32_bf16(Bt[n][k], At[m][k], acc[ai][bj][m][n], 0, 0, 0); } \
        __builtin_amdgcn_s_setprio(0); } while (0)
#define PG8_WAIT_V(n) asm volatile("s_waitcnt vmcnt(" #n ")" ::: "memory")
#define PG8_WAIT_L(n) asm volatile("s_waitcnt lgkmcnt(" #n ")" ::: "memory")
#define PG8_BAR __builtin_amdgcn_s_barrier()
#define PG8_SCHED __builtin_amdgcn_sched_barrier(0)
#define PG8_AOFFS(u, dst) do { const int _tq = wid * 64 + lane_id_v();   \
        _Pragma("unroll") for (int _i = 0; _i < 2; ++_i) { int _R, _C; stage_rc(_tq * 16 + _i * 8192, _R, _C); \
        _Pragma("unroll") for (int _h = 0; _h < 2; ++_h) { \
        const int _r = _h * HALF + _R; int _row; \
        if ((u).tok) { const int _rc = _r < (u).nvalid ? _r : (u).nvalid - 1; _row = (u).tok[_rc]; } else _row = (u).arow0 + _r; \
        dst[_h][_i] = (unsigned)_row * (unsigned)(K * 2) + (unsigned)(_C * 2); } } } while (0)
    unsigned ab8_ = (unsigned)(uintptr_t)(lds + aoff), bb8_ = (unsigned)(uintptr_t)(lds + boff) + 65536u;
    asm volatile("" : "+v"(ab8_), "+v"(bb8_));
    const LAS unsigned char* abase8 = (const LAS unsigned char*)(uintptr_t)ab8_; const LAS unsigned char* bbase8 = (const LAS unsigned char*)(uintptr_t)bb8_;
    Unit cur, nxt; int ui = 0;
    if (!S.next(0, cur)) return;
    f32x4 acc[2][2][4][2];
#pragma unroll
    for (int a = 0; a < 2; ++a)
#pragma unroll
        for (int b = 0; b < 2; ++b)
#pragma unroll
            for (int m = 0; m < 4; ++m)
#pragma unroll
                for (int n = 0; n < 2; ++n) acc[a][b][m][n] = (f32x4){0.f, 0.f, 0.f, 0.f};
    bf16x8 At[4][2] = {}, B0[2][2] = {}, B1[2][2] = {};
    v8i32 At8[4] = {}, B08[2] = {}, B18[2] = {};
    unsigned ao[2][2], an[2][2];
    PG8_AOFFS(cur, ao);
    const char* cB = cur.B;
    PG8_STAGEB(PG8_SB(0, 0), cB); PG8_STAGEB(PG8_SB(0, 1), cB + hstepB); PG8_STAGEA(PG8_SA(0, 0), 0, ao[0][0], ao[0][1]); PG8_STAGEA(PG8_SA(0, 1), 0, ao[1][0], ao[1][1]);
    if (wr == 1) PG8_BAR;
    PG8_WAIT_V(2); PG8_BAR;
    PG8_STAGEB(PG8_SB(1, 0), cB + kstep); PG8_STAGEA(PG8_SA(1, 0), kstep, ao[0][0], ao[0][1]); PG8_STAGEB(PG8_SB(1, 1), cB + hstepB + kstep);
    PG8_WAIT_V(6); PG8_BAR;
    for (;;) {
        const bool has_next = S.next(ui + 1, nxt);
        const char* nB = has_next ? nxt.B : cB;
        if (Sched::GATHER) {
            if (has_next) { PG8_AOFFS(nxt, an); } else {
#pragma unroll
                for (int h = 0; h < 2; ++h)
#pragma unroll
                    for (int i = 0; i < 2; ++i) an[h][i] = ao[h][i]; } }
        for (int t = 0; t < nt; t += 2) {
            const bool last = (t == nt - 2);
            if (!Sched::GATHER) {
                const Unit& un_ = (last && has_next) ? nxt : cur; PG8_AOFFS(un_, an); }
            const size_t k1 = (size_t)(t + 1) * kstep;
            const size_t k2 = last ? 0 : (size_t)(t + 2) * kstep, k3 = k2 + kstep;
            const char* b2 = last ? nB : cB + (size_t)(t + 2) * kstep; const char* b3 = b2 + kstep;
            const unsigned a200 = last ? an[0][0] : ao[0][0], a201 = last ? an[0][1] : ao[0][1], a210 = last ? an[1][0] : ao[1][0], a211 = last ? an[1][1] : ao[1][1];
            PG8_LDB(B0, 0, 0); PG8_LDB(B1, 0, 1); PG8_SCHED; PG8_LDA(At, 0, 0); PG8_STAGEA(PG8_SA(1, 1), k1, ao[1][0], ao[1][1]);
            PG8_WAIT_V(8); PG8_WAIT_L(0); PG8_BAR; PG8_MMA(0, 0, At, B0); PG8_MMA(0, 1, At, B1); PG8_BAR; PG8_SCHED;
            PG8_LDA(At, 0, 1); PG8_STAGEB(PG8_SB(0, 0), b2); PG8_STAGEB(PG8_SB(0, 1), b2 + hstepB); PG8_STAGEA(PG8_SA(0, 0), k2, a200, a201);
            PG8_WAIT_V(8); PG8_WAIT_L(0); PG8_BAR; PG8_MMA(1, 0, At, B0); PG8_MMA(1, 1, At, B1); PG8_BAR; PG8_SCHED;
            PG8_LDB(B0, 1, 0); PG8_LDB(B1, 1, 1); PG8_SCHED; PG8_LDA(At, 1, 0); PG8_STAGEA(PG8_SA(0, 1), k2, a210, a211);
            PG8_WAIT_V(8); PG8_WAIT_L(0); PG8_BAR; PG8_MMA(0, 0, At, B0); PG8_MMA(0, 1, At, B1); PG8_BAR; PG8_SCHED;
            PG8_LDA(At, 1, 1); PG8_STAGEB(PG8_SB(1, 0), b3); PG8_STAGEB(PG8_SB(1, 1), b3 + hstepB); PG8_STAGEA(PG8_SA(1, 0), k3, a200, a201);
            PG8_WAIT_V(8); PG8_WAIT_L(0); PG8_BAR; PG8_MMA(1, 0, At, B0); PG8_MMA(1, 1, At, B1); PG8_BAR; PG8_SCHED;
        }
        if (wr == 0) PG8_BAR;
        { const int lz_ = lane_id_v();
          E(acc, cur, wr, wc, lz_ & 15, lz_ >> 4); }
        if (!has_next) break;
#pragma unroll
        for (int a = 0; a < 2; ++a)
#pragma unroll
            for (int b = 0; b < 2; ++b)
#pragma unroll
                for (int m = 0; m < 4; ++m)
#pragma unroll
                    for (int n = 0; n < 2; ++n) acc[a][b][m][n] = (f32x4){0.f, 0.f, 0.f, 0.f};
        cur = nxt; cB = nB; ++ui;
#pragma unroll
        for (int h = 0; h < 2; ++h)
#pragma unroll
            for (int i = 0; i < 2; ++i) ao[h][i] = an[h][i];
        if (wr == 1) PG8_BAR;
    }
    PG8_WAIT_V(0);
    PG8_BAR;
#undef PG8_SA
#undef PG8_SB
#undef PG8_STAGEA
#undef PG8_STAGEB
#undef PG8_LDA
#undef PG8_LDB
#undef PG8_MMA
#undef PG8_RD16
#undef PG8_WAIT_V
#undef PG8_WAIT_L
#undef PG8_BAR
#undef PG8_SCHED
#undef PG8_AOFFS
}

struct GridOrder {
    static constexpr bool GATHER = false;
    int nM, nN, nwg, G, c; const char* Bt; size_t bstep;
    DI void init(int nM_, int nN_, int G_, int c_, const void* Bt_, int K) { nM = nM_; nN = nN_; nwg = nM * nN; G = G_; c = c_; Bt = (const char*)Bt_; bstep = (size_t)256 * K * 2; }
    DI bool next(int i, Unit& u) const {
        const int L = i * G + c; if (L >= nwg) return false;
        int wgid = L; { const int q = nwg / 8, r = nwg % 8, xcd = wgid % 8, off = wgid / 8; wgid = (xcd < r ? xcd * (q + 1) : r * (q + 1) + (xcd - r) * q) + off; }
        const int nig = 8 * nN, gid = wgid / nig, fm = gid * 8, gsz = (nM - fm) < 8 ? (nM - fm) : 8;
        u.pm = fm + ((wgid % nig) % gsz); u.pn = (wgid % nig) / gsz;
        u.B = Bt + (size_t)u.pn * bstep; u.arow0 = u.pm * 256; u.tok = nullptr; u.nvalid = 256; u.e = 0; return true;
    }
};
struct RowOrder {
    static constexpr bool GATHER = false;
    int nwg, G, c; const char* Bt; size_t bstep;
    DI bool next(int i, Unit& u) const {
        const int L = i * G + c; if (L >= nwg) return false;
        u.pm = L >> 3; u.pn = L & 7; u.B = Bt + (size_t)u.pn * bstep; u.arow0 = u.pm * 256; u.tok = nullptr; u.nvalid = 256; u.e = 0; return true;
    }
};
}
namespace pg8 {
#define EPI_ROWS(ai, m) ((ai) * HALF + wr * 64 + (m) * 16 + fr)
#define EPI_COL(bj) ((bj) * HALF + wc * 32 + 8 * fq)
DI u32x2 pack8_f8(const f32x4 v0, const f32x4 v1) {
    unsigned a = 0u, b = 0u;
    a = __builtin_amdgcn_cvt_pk_fp8_f32(v0[0], v0[1], a, false); a = __builtin_amdgcn_cvt_pk_fp8_f32(v0[2], v0[3], a, true);
    b = __builtin_amdgcn_cvt_pk_fp8_f32(v1[0], v1[1], b, false); b = __builtin_amdgcn_cvt_pk_fp8_f32(v1[2], v1[3], b, true);
    u32x2 w; w.x = a; w.y = b; return w;
}
DI unsigned xor8(unsigned v) { return (unsigned)__builtin_amdgcn_update_dpp(0, (int)v, 0x128, 0xF, 0xF, false); }
DI u32x4 xor8(const u32x4 v) { u32x4 r; r.x = xor8(v.x); r.y = xor8(v.y); r.z = xor8(v.z); r.w = xor8(v.w); return r; }
#define EPI_CM64_SWAP(p0, p1, d1, d2) do { const bool hi_ = fr >= 8; const u32x4 snd_ = hi_ ? (p0) : (p1); const u32x4 rcv_ = xor8(snd_); d1 = hi_ ? rcv_ : (p0); d2 = hi_ ? (p1) : rcv_; } while (0)
#define EPI_CM64_ROW(ai, m) ((ai) * HALF + wr * 64 + (m) * 16 + (fr & 7))
#define EPI_CM64_COL (wc * 64 + (fr >> 3) * 32 + 8 * fq)
DI u32x4 pack8(const f32x4 v0, const f32x4 v1) { u32x4 w; w.x = pk2(v0[0], v0[1]); w.y = pk2(v0[2], v0[3]); w.z = pk2(v1[0], v1[1]); w.w = pk2(v1[2], v1[3]); return w; }

struct EpiProj {
    static constexpr bool HAS_ROWSC = true;
    unsigned char* ws; const float* rs0;
    DI float row_scalar(const Unit& u, int r) const { return rs0[u.pm * BM + r]; }
    DI void operator()(const f32x4 (&acc)[2][2][4][2], const Unit& u, int wr, int wc, int fr, int fq) const {
        const int pn = u.pn, c = EPI_CM64_COL;
        const int tsr = pn >> 2; const float qs = (pn < 16 && (tsr == 0 || tsr == 3)) ? QSCALE : 1.0f;
#pragma unroll
        for (int ai = 0; ai < 2; ++ai)
#pragma unroll
            for (int m = 0; m < 4; ++m) {
                const int row = u.pm * BM + EPI_CM64_ROW(ai, m);
                const u32x4 p0 = pack8(acc[ai][0][m][0] * qs, acc[ai][0][m][1] * qs), p1 = pack8(acc[ai][1][m][0] * qs, acc[ai][1][m][1] * qs);
                u32x4 d1, d2; EPI_CM64_SWAP(p0, p1, d1, d2);
                if (pn < 16) {
                    bf16_t* dst = (bf16_t*)(ws + WS_MQ + (size_t)tsr * 64 * MiB) + (size_t)row * 1024 + (pn & 3) * 256 + c;
                    *(u32x4*)dst = d1; *(u32x4*)(dst + 8 * 1024) = d2;
                } else if (pn < 22) {
                    const int b = row >> 13, t = row & 8191, g = c >> 7, d = c & 127;
                    bf16_t* dst = (bf16_t*)(ws + WS_KC + (size_t)(pn - 16) * 16 * MiB) + ((size_t)(b * 2 + g) * NT + t) * HD + d;
                    *(u32x4*)dst = d1; *(u32x4*)(dst + 8 * HD) = d2;
                }
            }
    }
};
struct EpiNull {
    static constexpr bool HAS_ROWSC = false;
    DI float row_scalar(const Unit&, int) const { return 0.f; }
    DI void operator()(const f32x4 (&acc)[2][2][4][2], const Unit& u, int wr, int wc, int fr, int fq) const {
#pragma unroll
        for (int ai = 0; ai < 2; ++ai)
#pragma unroll
            for (int bj = 0; bj < 2; ++bj)
#pragma unroll
                for (int m = 0; m < 4; ++m)
#pragma unroll
                    for (int n = 0; n < 2; ++n) asm volatile("" :: "v"(acc[ai][bj][m][n]));
    }
};
struct EpiF32 {
    static constexpr bool HAS_ROWSC = false;
    DI float row_scalar(const Unit&, int) const { return 0.f; }
    float* C; int ldc;
    DI void operator()(const f32x4 (&acc)[2][2][4][2], const Unit& u, int wr, int wc, int fr, int fq) const {
        float* Cb = C + (size_t)u.e * 4096 * 256;
#pragma unroll
        for (int ai = 0; ai < 2; ++ai)
#pragma unroll
            for (int m = 0; m < 4; ++m) { float* rp = Cb + (size_t)(u.pm * BM + EPI_ROWS(ai, m)) * ldc + u.pn * BM;
#pragma unroll
                for (int bj = 0; bj < 2; ++bj) { const int c = EPI_COL(bj); *(f32x4*)(rp + c) = acc[ai][bj][m][0]; *(f32x4*)(rp + c + 4) = acc[ai][bj][m][1]; } }
    }
};
struct EpiBf16 {
    static constexpr bool HAS_ROWSC = false;
    DI float row_scalar(const Unit&, int) const { return 0.f; }
    bf16_t* O; int ldc;
    DI void operator()(const f32x4 (&acc)[2][2][4][2], const Unit& u, int wr, int wc, int fr, int fq) const {
#pragma unroll
        for (int ai = 0; ai < 2; ++ai)
#pragma unroll
            for (int m = 0; m < 4; ++m) { bf16_t* rp = O + (size_t)(u.pm * BM + EPI_ROWS(ai, m)) * ldc + u.pn * BM;
#pragma unroll
                for (int bj = 0; bj < 2; ++bj) *(u32x4*)(rp + EPI_COL(bj)) = pack8(acc[ai][bj][m][0], acc[ai][bj][m][1]); }
    }
};
struct EpiOut {
    static constexpr bool HAS_ROWSC = false;
    DI float row_scalar(const Unit&, int) const { return 0.f; }
    const float* x; bf16_t* xb; float* ssq; unsigned char* x8;
    DI void operator()(const f32x4 (&acc)[2][2][4][2], const Unit& u, int wr, int wc, int fr, int fq) const {
        f32x4 xa[2][2], xn[2][2]; float ssv[8];
#pragma unroll
        for (int bj = 0; bj < 2; ++bj) { const size_t o = (size_t)(u.pm * BM + EPI_ROWS(0, 0)) * DM + u.pn * BM + EPI_COL(bj); xa[bj][0] = *(const f32x4*)(x + o); xa[bj][1] = *(const f32x4*)(x + o + 4); }
#pragma unroll
        for (int i = 0; i < 8; ++i) {
            const int ai = i >> 2, m = i & 3;
            if (i + 1 < 8) {
#pragma unroll
                for (int bj = 0; bj < 2; ++bj) { const size_t o = (size_t)(u.pm * BM + EPI_ROWS((i + 1) >> 2, (i + 1) & 3)) * DM + u.pn * BM + EPI_COL(bj); xn[bj][0] = *(const f32x4*)(x + o); xn[bj][1] = *(const f32x4*)(x + o + 4); }
            }
            const int row = u.pm * BM + EPI_ROWS(ai, m); float ss = 0.f;
#pragma unroll
            for (int bj = 0; bj < 2; ++bj) { const size_t o = (size_t)row * DM + u.pn * BM + EPI_COL(bj);
                const f32x4 v0 = xa[bj][0] + acc[ai][bj][m][0] * (1.0f / WOUT_SCALE), v1 = xa[bj][1] + acc[ai][bj][m][1] * (1.0f / WOUT_SCALE);
                *(u32x4*)(xb + o) = pack8(v0, v1); if (F8GU) *(u32x2*)(x8 + o) = pack8_f8(v0, v1);
                ss += (v0[0] * v0[0] + v0[1] * v0[1]) + (v0[2] * v0[2] + v0[3] * v0[3]) + (v1[0] * v1[0] + v1[1] * v1[1]) + (v1[2] * v1[2] + v1[3] * v1[3]); }
            ss += __shfl_xor(ss, 16); ss += __shfl_xor(ss, 32);
            ssv[i] = ss;
#pragma unroll
            for (int bj = 0; bj < 2; ++bj) { xa[bj][0] = xn[bj][0]; xa[bj][1] = xn[bj][1]; }
        }
        if (fq == 0) {
#pragma unroll
            for (int i = 0; i < 8; ++i) atomicAdd(ssq + u.pm * BM + EPI_ROWS(i >> 2, i & 3), ssv[i]);
        }
    }
};
struct EpiGU {
    static constexpr bool HAS_ROWSC = false;
    unsigned char* H; const float* rsl; const float* rs1; const LAS int* pstart;
    DI float row_scalar(const Unit& u, int r) const { if (u.e < 64) { const int rc = r < u.nvalid ? r : u.nvalid - 1; return rsl[(size_t)u.e * 32768 + u.pm * 256 + rc]; } return rs1[u.pm * 256 + r]; }
    DI void operator()(const f32x4 (&acc)[2][2][4][2], const Unit& u, int wr, int wc, int fr, int fq) const {
        const int e = u.e, mt = u.pm, nt_ = u.pn;
        const unsigned rowbase = (unsigned)__builtin_amdgcn_readfirstlane(pstart[e]) + (unsigned)mt * 256u;
        const char* rb_ = (e < 64) ? (const char*)rsl + (unsigned)((e * 32768 + mt * 256) * 4) : (const char*)rs1 + (unsigned)(mt * 256 * 4);
        const int nv_ = (e < 64) ? u.nvalid : 256;
#define EPIGU_RS(i) (*(const float*)(rb_ + (unsigned)(((EPI_ROWS((i) >> 2, (i) & 3)) < nv_ ? (EPI_ROWS((i) >> 2, (i) & 3)) : nv_ - 1) * 4)))
        float rs_n = EPIGU_RS(0);
#pragma unroll
        for (int ai = 0; ai < 2; ++ai)
#pragma unroll
            for (int m = 0; m < 4; ++m) {
                const int r = EPI_ROWS(ai, m);
                float rs = rs_n;
                if (ai * 4 + m + 1 < 8) rs_n = EPIGU_RS(ai * 4 + m + 1);
                rs *= (1.0f / WGU_SCALE);
                f32x4 g0 = acc[ai][0][m][0] * rs, g1 = acc[ai][0][m][1] * rs, u0 = acc[ai][1][m][0] * rs, u1 = acc[ai][1][m][1] * rs, h0, h1;
#pragma unroll
                for (int j = 0; j < 4; ++j) { h0[j] = g0[j] * __builtin_amdgcn_rcpf(1.0f + __expf(-g0[j])) * u0[j]; h1[j] = g1[j] * __builtin_amdgcn_rcpf(1.0f + __expf(-g1[j])) * u1[j]; }
                const unsigned hoff = (rowbase + (unsigned)r) * (unsigned)DE + (unsigned)(nt_ * 128 + wc * 32 + 8 * fq);
                if (F8DN) *(u32x2*)(H + hoff) = pack8_f8(h0, h1); else *(u32x4*)(H + 2u * hoff) = pack8(h0, h1);
            }
    }
};
struct EpiDown {
    static constexpr bool HAS_ROWSC = true;
    unsigned char* Yp; bf16_t* xres; const LAS int* pstart;
    DI void operator()(const f32x4 (&acc)[2][2][4][2], const Unit& u, int wr, int wc, int fr, int fq) const {
        const int e = u.e, mt = u.pm;
        if (e < 64) {
            const unsigned rowbase = (unsigned)__builtin_amdgcn_readfirstlane(pstart[e]) + (unsigned)mt * 256u;
#pragma unroll
            for (int ai = 0; ai < 2; ++ai)
#pragma unroll
                for (int m = 0; m < 4; ++m) {
                    const int r = EPI_ROWS(ai, m);
                    { const u32x2 y0 = pack8_f8(acc[ai][0][m][0] * (YP_SCALE / WD_SCALE), acc[ai][0][m][1] * (YP_SCALE / WD_SCALE)), y1 = pack8_f8(acc[ai][1][m][0] * (YP_SCALE / WD_SCALE), acc[ai][1][m][1] * (YP_SCALE / WD_SCALE));
                      u32x4 y; y.x = y0.x; y.y = y0.y; y.z = y1.x; y.w = y1.y;
                      *(u32x4*)((char*)Yp + (unsigned)((((rowbase >> 8) * 8u + (unsigned)u.pn) * 256u + (unsigned)r) * 256u + (unsigned)(wc * 64 + fq * 16))) = y; }
                }
        } else if (xres) {
#pragma unroll
            for (int ai = 0; ai < 2; ++ai) {
                u32x4 old[4][2];
#pragma unroll
                for (int m = 0; m < 4; ++m)
#pragma unroll
                    for (int bj = 0; bj < 2; ++bj) old[m][bj] = *(const u32x4*)((const char*)xres + (unsigned)(((unsigned)(mt * 256 + EPI_ROWS(ai, m)) * (unsigned)DM + (unsigned)(u.pn * 256 + EPI_COL(bj))) * 2u));
#pragma unroll
                for (int m = 0; m < 4; ++m)
#pragma unroll
                    for (int bj = 0; bj < 2; ++bj) { u32x4* o = (u32x4*)((char*)xres + (unsigned)(((unsigned)(mt * 256 + EPI_ROWS(ai, m)) * (unsigned)DM + (unsigned)(u.pn * 256 + EPI_COL(bj))) * 2u)); const u32x4 od = old[m][bj];
                        f32x4 v0 = acc[ai][bj][m][0] * (1.0f / WD_SCALE), v1 = acc[ai][bj][m][1] * (1.0f / WD_SCALE);
                        v0[0] += bflo(od.x); v0[1] += bfhi(od.x); v0[2] += bflo(od.y); v0[3] += bfhi(od.y); v1[0] += bflo(od.z); v1[1] += bfhi(od.z); v1[2] += bflo(od.w); v1[3] += bfhi(od.w);
                        *o = pack8(v0, v1); }
            }
        }
    }
};
struct EpiPleFin {
    static constexpr bool HAS_ROWSC = true;
    const bf16_t* xres; float* out; const bf16_t* PP; const float* rs2; float* ssq; unsigned* arrive; const float* gfin;
    DI float row_scalar(const Unit& u, int r) const { return rs2[u.pm * BM + r]; }
    DI void operator()(f32x4 (&acc)[2][2][4][2], const Unit& u, int wr, int wc, int fr, int fq) const {
        float ssv[8];
#pragma unroll
        for (int ai = 0; ai < 2; ++ai)
#pragma unroll
            for (int m = 0; m < 4; ++m) {
                const int row = u.pm * BM + EPI_ROWS(ai, m); const float rs = rs2[row] * (1.0f / WPG_SCALE); float ss = 0.f;
#pragma unroll
                for (int bj = 0; bj < 2; ++bj) { const size_t o = (size_t)row * DM + u.pn * BM + EPI_COL(bj);
                    const u32x4 pp = *(const u32x4*)(PP + o), xr = *(const u32x4*)(xres + o);
                    const f32x4 p0 = {bflo(pp.x), bfhi(pp.x), bflo(pp.y), bfhi(pp.y)}, p1 = {bflo(pp.z), bfhi(pp.z), bflo(pp.w), bfhi(pp.w)};
                    f32x4 v0 = {bflo(xr.x), bfhi(xr.x), bflo(xr.y), bfhi(xr.y)}, v1 = {bflo(xr.z), bfhi(xr.z), bflo(xr.w), bfhi(xr.w)};
#pragma unroll
                    for (int j = 0; j < 4; ++j) { v0[j] += p0[j] * __builtin_amdgcn_rcpf(1.0f + __expf(-rs * acc[ai][bj][m][0][j])); v1[j] += p1[j] * __builtin_amdgcn_rcpf(1.0f + __expf(-rs * acc[ai][bj][m][1][j])); }
                    acc[ai][bj][m][0] = v0; acc[ai][bj][m][1] = v1;
                    ss += (v0[0] * v0[0] + v0[1] * v0[1]) + (v0[2] * v0[2] + v0[3] * v0[3]) + (v1[0] * v1[0] + v1[1] * v1[1]) + (v1[2] * v1[2] + v1[3] * v1[3]); }
                ss += __shfl_xor(ss, 16); ss += __shfl_xor(ss, 32);
                ssv[ai * 4 + m] = ss;
            }
        if (fq == 0) {
#pragma unroll
            for (int i = 0; i < 8; ++i) atomicAdd(ssq + u.pm * BM + EPI_ROWS(i >> 2, i & 3), ssv[i]);
        }
        asm volatile("s_waitcnt vmcnt(0)" ::: "memory");
        __syncthreads();
        if (wr == 0 && wc == 0 && fr == 0 && fq == 0) {
            unsigned* a = arrive + (size_t)u.pm * 32;
            (void)__hip_atomic_fetch_add(a, 1u, __ATOMIC_RELAXED, __HIP_MEMORY_SCOPE_AGENT);
            while (__hip_atomic_load(a, __ATOMIC_RELAXED, __HIP_MEMORY_SCOPE_AGENT) < 8u) __builtin_amdgcn_s_sleep(2);
        }
        __syncthreads();
        f32x4 g[2][2];
#pragma unroll
        for (int bj = 0; bj < 2; ++bj) { const float* gp = gfin + u.pn * BM + EPI_COL(bj); g[bj][0] = *(const f32x4*)gp; g[bj][1] = *(const f32x4*)(gp + 4); }
        float svv[8];
#pragma unroll
        for (int i = 0; i < 8; ++i) svv[i] = __hip_atomic_load(ssq + u.pm * BM + EPI_ROWS(i >> 2, i & 3), __ATOMIC_RELAXED, __HIP_MEMORY_SCOPE_AGENT);
#pragma unroll
        for (int ai = 0; ai < 2; ++ai)
#pragma unroll
            for (int m = 0; m < 4; ++m) {
                const int row = u.pm * BM + EPI_ROWS(ai, m);
                const float rs3 = __builtin_amdgcn_rsqf(svv[ai * 4 + m] * (1.0f / DM) + EPS);
#pragma unroll
                for (int bj = 0; bj < 2; ++bj) { float* op = out + (size_t)row * DM + u.pn * BM + EPI_COL(bj);
                    *(f32x4*)op = acc[ai][bj][m][0] * rs3 * g[bj][0]; *(f32x4*)(op + 4) = acc[ai][bj][m][1] * rs3 * g[bj][1]; }
            }
    }
};
#undef EPIGU_RS
#undef EPI_ROWS
#undef EPI_COL
#undef EPI_CM64_SWAP
#undef EPI_CM64_ROW
#undef EPI_CM64_COL

struct CmpOrder {
    static constexpr bool GATHER = false;
    int G, c; const char* W1K; const char* W1V;
    DI bool next(int i, Unit& u) const {
        const int L = i * G + c; if (L >= 32) return false;
        u.e = L >> 4; u.pm = L & 15; u.pn = 0; u.arow0 = L * 256;
        u.B = u.e ? W1V : W1K; u.tok = nullptr; u.nvalid = 256; return true;
    }
};
template <bool GATHER_, int NTLOG = 2> struct MoeOrder {
    static constexpr bool GATHER = GATHER_;
    int G, c; const LAS int* mtoff; const LAS int* cnt; int total;
    const char* Wbase; size_t estep, nstep; int pn0;
    const int* tokl; bool gather; const LAS int* pstart;
    DI bool next(int i, Unit& u) const {
        const int L = i * G + c; if (L >= total) return false;
        const int g = L >> NTLOG, nt_ = L & ((1 << NTLOG) - 1);
        int lo = 0, hi = 65;
        while (hi - lo > 1) { const int mid = (lo + hi) >> 1; if (mtoff[mid] <= g) lo = mid; else hi = mid; }
        const int e = __builtin_amdgcn_readfirstlane(lo), mt = __builtin_amdgcn_readfirstlane(g - mtoff[lo]);
        u.e = e; u.pm = mt; u.pn = pn0 + nt_;
        u.B = Wbase + (size_t)e * estep + (size_t)(pn0 + nt_) * nstep;
        const int ce = __builtin_amdgcn_readfirstlane(cnt[e]); u.nvalid = (ce - mt * 256) < 256 ? (ce - mt * 256) : 256;
        if (gather) { u.tok = (e < 64) ? tokl + (size_t)e * 32768 + mt * 256 : nullptr; u.arow0 = mt * 256; }
        else { u.tok = nullptr; u.arow0 = __builtin_amdgcn_readfirstlane(pstart[e]) + mt * 256; }
        return true;
    }
};
}
namespace att {
constexpr int VP = 320;
constexpr int KT_BYTES = 64 * 256, VT_BYTES = 64 * VP, BUF_BYTES = KT_BYTES + VT_BYTES;
constexpr int SCR_OFF = 2 * BUF_BYTES;
constexpr float THR = 8.0f, MASKV = -3.0e38f, MINIT = -1.0e30f;
#define KSWZ(row, colB) ((row) * 256 + ((colB) ^ (((row) & 7) << 4)))
#define CRC(r) (((r) & 3) + 8 * ((r) >> 2))
#define MFMA32(a, b, c) __builtin_amdgcn_mfma_f32_32x32x16_bf16((a), (b), (c), 0, 0, 0)

struct Stage { u32x4 k0, k1, v0, v1; };
DI void stage_load(Stage& s, const bf16_t* Kt, const bf16_t* Vt, int ld, int sr, int sc) {
    s.k0 = *(const u32x4*)(Kt + (size_t)sr * ld + sc); s.k1 = *(const u32x4*)(Kt + (size_t)(32 + sr) * ld + sc);
    s.v0 = *(const u32x4*)(Vt + (size_t)sr * ld + sc); s.v1 = *(const u32x4*)(Vt + (size_t)(32 + sr) * ld + sc);
}
DI void stage_write(const Stage& s, LAS unsigned char* buf, int sr, int sc) {
    *(LAS u32x4*)(buf + KSWZ(sr, sc * 2)) = s.k0; *(LAS u32x4*)(buf + KSWZ(32 + sr, sc * 2)) = s.k1;
    *(LAS u32x4*)(buf + KT_BYTES + sr * VP + sc * 2) = s.v0; *(LAS u32x4*)(buf + KT_BYTES + (32 + sr) * VP + sc * 2) = s.v1;
}
DI void qk_tile(f32x16& p0, f32x16& p1, const LAS unsigned char* Ks, const bf16x8 (&qr)[8], int r32, int hw, float ks, float base) {
    float ksl = ks; asm volatile("" : "+v"(ksl));
#pragma unroll
    for (int i = 0; i < 16; ++i) { p0[i] = fmaf(ksl, (float)CRC(i), base); p1[i] = fmaf(ksl, (float)(CRC(i) + 32), base); }
    const int x = (r32 & 7) << 4, lo4 = (hw << 4) ^ (x & 0x10);
    const LAS unsigned char* kb[4];
#pragma unroll
    for (int k = 0; k < 4; ++k) kb[k] = Ks + r32 * 256 + (((k << 5) ^ (x & 0x60)) | lo4);
#pragma unroll
    for (int hb = 0; hb < 2; ++hb) {
        bf16x8 a0[4], a1[4];
#pragma unroll
        for (int k = 0; k < 4; ++k) { a0[k] = *(const LAS bf16x8*)(kb[k] + hb * 128); a1[k] = *(const LAS bf16x8*)(kb[k] + hb * 128 + 8192); }
        asm volatile("s_waitcnt lgkmcnt(0)" ::: "memory"); __builtin_amdgcn_sched_barrier(0);
#pragma unroll
        for (int k = 0; k < 4; ++k) { p0 = MFMA32(a0[k], qr[4 * hb + k], p0); p1 = MFMA32(a1[k], qr[4 * hb + k], p1); }
        __builtin_amdgcn_sched_barrier(0);
    }
}
template <int OFF> DI s16x4 tr_read(unsigned vb) { s16x4 r; asm volatile("ds_read_b64_tr_b16 %0, %1 offset:%2" : "=&v"(r) : "v"(vb), "i"(OFF) : "memory"); return r; }
constexpr int v_off(int tt, int s, int half, int d0) { return tt * 32 * VP + s * 16 * VP + half * 8 * VP + d0 * 64; }
DI unsigned v_rd_base(const LAS unsigned char* Vs, int lane) { const int q = (lane & 15) >> 2, p = lane & 3, blk = (lane >> 4) & 1, hw = lane >> 5; return (unsigned)(uintptr_t)Vs + (4 * hw + q) * VP + (16 * blk + 4 * p) * 2; }
template <int D0> DI void pv_one(f32x16& od, unsigned vb, bf16x8 pa, bf16x8 pb, bf16x8 pc, bf16x8 pd) {
    const s16x4 l0 = tr_read<v_off(0, 0, 0, D0)>(vb), h0 = tr_read<v_off(0, 0, 1, D0)>(vb), l1 = tr_read<v_off(0, 1, 0, D0)>(vb), h1 = tr_read<v_off(0, 1, 1, D0)>(vb);
    const s16x4 l2 = tr_read<v_off(1, 0, 0, D0)>(vb), h2 = tr_read<v_off(1, 0, 1, D0)>(vb), l3 = tr_read<v_off(1, 1, 0, D0)>(vb), h3 = tr_read<v_off(1, 1, 1, D0)>(vb);
    asm volatile("s_waitcnt lgkmcnt(0)" ::: "memory"); __builtin_amdgcn_sched_barrier(0);
#define PKV(L, H) (bf16x8){L[0], L[1], L[2], L[3], H[0], H[1], H[2], H[3]}
    od = MFMA32(PKV(l0, h0), pa, od); od = MFMA32(PKV(l1, h1), pb, od); od = MFMA32(PKV(l2, h2), pc, od); od = MFMA32(PKV(l3, h3), pd, od);
#undef PKV
}
DI void pv_tile(f32x16 (&o)[4], unsigned vb, bf16x8 pa, bf16x8 pb, bf16x8 pc, bf16x8 pd) {
    pv_one<0>(o[0], vb, pa, pb, pc, pd); pv_one<1>(o[1], vb, pa, pb, pc, pd); pv_one<2>(o[2], vb, pa, pb, pc, pd); pv_one<3>(o[3], vb, pa, pb, pc, pd);
}
DI float half_max(float v) { auto rr = __builtin_amdgcn_permlane32_swap(__float_as_uint(v), __float_as_uint(v), false, false); return fmaxf(__uint_as_float(rr[0]), __uint_as_float(rr[1])); }
DI float half_sum(float v) { auto rr = __builtin_amdgcn_permlane32_swap(__float_as_uint(v), __float_as_uint(v), false, false); return __uint_as_float(rr[0]) + __uint_as_float(rr[1]); }
DI bf16x8 pack_half(const f32x16& p, int s) {
    u32x4 w; w.x = pk2(p[8 * s + 0], p[8 * s + 1]); w.y = pk2(p[8 * s + 2], p[8 * s + 3]); w.z = pk2(p[8 * s + 4], p[8 * s + 5]); w.w = pk2(p[8 * s + 6], p[8 * s + 7]);
    return __builtin_bit_cast(bf16x8, w);
}
template <bool MASK> DI float mask_max(f32x16& p0, f32x16& p1, int lo_, int hi_) {
    float mx = MASKV;
#pragma unroll
    for (int r = 0; r < 16; ++r) { if (MASK) p0[r] = (CRC(r) >= lo_ && CRC(r) <= hi_) ? p0[r] : MASKV; mx = fmaxf(mx, p0[r]); }
#pragma unroll
    for (int r = 0; r < 16; ++r) { if (MASK) p1[r] = (CRC(r) + 32 >= lo_ && CRC(r) + 32 <= hi_) ? p1[r] : MASKV; mx = fmaxf(mx, p1[r]); }
    return mx;
}
template <bool MASK> DI void softmax_tile(f32x16& p0, f32x16& p1, float& m, float& l, f32x16 (&o)[4], int lo_, int hi_,
                                          bf16x8& pa, bf16x8& pb, bf16x8& pc, bf16x8& pd) {
    const float mx = half_max(mask_max<MASK>(p0, p1, lo_, hi_));
    {
        const float mn = fmaxf(m, mx), alpha = __builtin_amdgcn_exp2f(m - mn);
#pragma unroll
        for (int d = 0; d < 4; ++d)
#pragma unroll
            for (int r = 0; r < 16; ++r) o[d][r] *= alpha;
        l *= alpha; m = mn;
    }
    float ps = 0.f;
#pragma unroll
    for (int r = 0; r < 16; ++r) { p0[r] = __builtin_amdgcn_exp2f(p0[r] - m); ps += p0[r]; }
#pragma unroll
    for (int r = 0; r < 16; ++r) { p1[r] = __builtin_amdgcn_exp2f(p1[r] - m); ps += p1[r]; }
    l += half_sum(ps);
    pa = pack_half(p0, 0); pb = pack_half(p0, 1); pc = pack_half(p1, 0); pd = pack_half(p1, 1);
}
DI void store_o(bf16_t* orow  , const f32x16 (&o)[4], float sc, int hw, bool accumulate) {
#pragma unroll
    for (int d0 = 0; d0 < 4; ++d0)
#pragma unroll
        for (int g = 0; g < 4; ++g) {
            u32x2* p = (u32x2*)(orow + 32 * d0 + 8 * g + 4 * hw);
            float a = o[d0][4 * g] * sc, b = o[d0][4 * g + 1] * sc, c = o[d0][4 * g + 2] * sc, d = o[d0][4 * g + 3] * sc;
            if (accumulate) { const u32x2 old = *p; a += bflo(old.x); b += bfhi(old.x); c += bflo(old.y); d += bfhi(old.y); }
            u32x2 w; w.x = pk2(a, b); w.y = pk2(c, d); *p = w;
        }
}
DI void zero_o(f32x16 (&o)[4]) {
#pragma unroll
    for (int d = 0; d < 4; ++d)
#pragma unroll
        for (int r = 0; r < 16; ++r) o[d][r] = 0.f;
}

DI bool better(float av, int ai, float bv, int bi) { return av > bv || (av == bv && ai < bi); }
DI void ins3(float v, int i, float& v1, int& i1, float& v2, int& i2, float& v3, int& i3) {
    const bool b1 = better(v, i, v1, i1), b2 = better(v, i, v2, i2), b3 = better(v, i, v3, i3);
    const float n3v = b2 ? v2 : (b3 ? v : v3); const int n3i = b2 ? i2 : (b3 ? i : i3);
    const float n2v = b1 ? v1 : (b2 ? v : v2); const int n2i = b1 ? i1 : (b2 ? i : i2);
    const float n1v = b1 ? v : v1; const int n1i = b1 ? i : i1;
    v1 = n1v; i1 = n1i; v2 = n2v; i2 = n2i; v3 = n3v; i3 = n3i;
}
DI void moba_store_partial(const PArgs& P, int b, int t, int h, int rank, const f32x16 (&o)[4], float m, float l, int hw) {
    const size_t pi = ((size_t)(b * NT + t) * 8 + h) * 4 + rank;
    store_o((bf16_t*)P.out + pi * HD, o, l > 0.f ? 1.0f / l : 0.f, hw, false);
    if (hw == 0) { f32x2 v = {m, l}; ((f32x2*)(P.ws + WS_ML))[pi] = v; }
}
DI void moba_gate_unit(const PArgs& P, int b, int h, int bt) {
    int tid = P.tid; asm volatile("" : "+v"(tid));
    const int lane = tid & 63, wave = P.wave, r32 = lane & 31, hw = lane >> 5;
    unsigned char* ws = P.ws;
    const int t = bt * 256 + wave * 32 + r32;
    const bf16_t* Q = (const bf16_t*)(ws + WS_MQ) + ((size_t)(b * NT + t) * 8 + h) * HD + hw * 8;
    bf16x8 qr[8];
#pragma unroll
    for (int d0 = 0; d0 < 8; ++d0) qr[d0] = *(const bf16x8*)(Q + 16 * d0);
    const float slope2 = __int_as_float(__builtin_amdgcn_readfirstlane(__float_as_int(exp2f(-((float)h + 0.5f)) * LOG2E)));
    LAS unsigned* gcnt = (LAS unsigned*)(P.lds + 134144);
    LAS unsigned* gbase = gcnt + 32;
    if (tid < 32) gcnt[tid] = 0u;
    __syncthreads();
    const bf16_t* Kb = (const bf16_t*)(ws + WS_MK) + ((size_t)(b * NT + bt * 256) * 8 + h) * HD;
    const bf16_t* Vb = (const bf16_t*)(ws + WS_MV) + ((size_t)(b * NT + bt * 256) * 8 + h) * HD;
    Stage st; stage_load(st, Kb, Vb, 1024, tid >> 4, (tid & 15) * 8);
    {
        const float NINF = -__builtin_inff();
        float v1 = NINF, v2 = NINF, v3 = NINF; int i1 = 99, i2 = 100, i3 = 101;
        if (bt > 0) {
            f32x16 g;
#pragma unroll
            for (int i = 0; i < 16; ++i) g[i] = 0.f;
            const bf16_t* km = (const bf16_t*)(ws + WS_KMEAN) + ((size_t)(b * 8 + h) * 32 + r32) * HD + hw * 8;
#pragma unroll
            for (int d0 = 0; d0 < 8; ++d0) g = MFMA32(*(const bf16x8*)(km + 16 * d0), qr[d0], g);
#pragma unroll
            for (int i = 0; i < 16; ++i) { const int blk = CRC(i) + 4 * hw; const float v = blk < bt ? g[i] : NINF; ins3(v, blk, v1, i1, v2, i2, v3, i3); }
            const float w1 = __shfl_xor(v1, 32), w2 = __shfl_xor(v2, 32), w3 = __shfl_xor(v3, 32);
            const int j1 = __shfl_xor(i1, 32), j2 = __shfl_xor(i2, 32), j3 = __shfl_xor(i3, 32);
            ins3(w1, j1, v1, i1, v2, i2, v3, i3); ins3(w2, j2, v1, i1, v2, i2, v3, i3); ins3(w3, j3, v1, i1, v2, i2, v3, i3);
        }
        if (hw == 0) {
            const size_t pi = ((size_t)(b * NT + t) * 8 + h) * 4; f32x2 e = {MINIT, 0.f};
            ((f32x2*)(ws + WS_ML))[pi] = e; ((f32x2*)(ws + WS_ML))[pi + 1] = e; ((f32x2*)(ws + WS_ML))[pi + 2] = e;
        }
        unsigned s1 = 0u, s2 = 0u, s3 = 0u;
        if (hw == 0) {
            if (v1 > NINF) s1 = __hip_atomic_fetch_add(gcnt + i1, 1u, __ATOMIC_RELAXED, __HIP_MEMORY_SCOPE_WORKGROUP);
            if (v2 > NINF) s2 = __hip_atomic_fetch_add(gcnt + i2, 1u, __ATOMIC_RELAXED, __HIP_MEMORY_SCOPE_WORKGROUP);
            if (v3 > NINF) s3 = __hip_atomic_fetch_add(gcnt + i3, 1u, __ATOMIC_RELAXED, __HIP_MEMORY_SCOPE_WORKGROUP);
        }
        __syncthreads();
        if (tid < 32) { const unsigned c = gcnt[tid]; gbase[tid] = c ? atomicAdd((unsigned*)(ws + WS_CTL) + CTLW_LCNT + (b * 8 + h) * 32 + tid, c) : 0u; }
        __syncthreads();
        if (hw == 0) {
            int* lists = (int*)(ws + WS_LIST) + (size_t)((b * 8 + h) * 32) * 8192;
            if (v1 > NINF) lists[(size_t)i1 * 8192 + gbase[i1] + s1] = t | (0 << 16);
            if (v2 > NINF) lists[(size_t)i2 * 8192 + gbase[i2] + s2] = t | (1 << 16);
            if (v3 > NINF) lists[(size_t)i3 * 8192 + gbase[i3] + s3] = t | (2 << 16);
        }
    }
    float m = MINIT, l = 0.f; f32x16 o[4]; zero_o(o);
#pragma unroll
    for (int kt = 0; kt < 4; ++kt) {
        int tz = tid; asm volatile("" : "+v"(tz));
        const int lz = tz & 63, r32z = lz & 31, hwz = lz >> 5, srz = tz >> 4, scz = (tz & 15) * 8;
        LAS unsigned char* buf = P.lds + (kt & 1) * BUF_BYTES;
        stage_write(st, buf, srz, scz);
        __syncthreads();
        if (kt + 1 < 4) stage_load(st, Kb + (size_t)(64 * (kt + 1)) * 1024, Vb + (size_t)(64 * (kt + 1)) * 1024, 1024, srz, scz);
        const int q0 = wave * 32;
        {
            f32x16 p0, p1; bf16x8 pa, pb, pc, pd;
            qk_tile(p0, p1, buf, qr, r32z, hwz, slope2, slope2 * (float)(64 * kt + 4 * hwz - (q0 + r32z)));
            softmax_tile<true>(p0, p1, m, l, o, -1000 - 4 * hwz, q0 + r32z - kt * 64 - 4 * hwz, pa, pb, pc, pd);
            pv_tile(o, v_rd_base(buf + KT_BYTES, lz), pa, pb, pc, pd);
        }
    }
    { int tz = tid; asm volatile("" : "+v"(tz)); const int lz = tz & 63; moba_store_partial(P, b, bt * 256 + wave * 32 + (lz & 31), h, 3, o, m, l, lz >> 5); }
    __syncthreads();
}
DI void moba_item(const PArgs& P, int lid, int c256) {
    unsigned char* ws = P.ws;
    const int cnt = (int)__hip_atomic_load((const unsigned*)(ws + WS_CTL) + CTLW_LCNT + lid, __ATOMIC_RELAXED, __HIP_MEMORY_SCOPE_AGENT);
    if (c256 * 256 >= cnt) return;
    int tid = P.tid; asm volatile("" : "+v"(tid));
    const int lane = tid & 63, wave = P.wave, r32 = lane & 31, hw = lane >> 5;
    const int b = lid >> 8, h = (lid >> 5) & 7, j = lid & 31;
    const int idx = c256 * 256 + wave * 32 + r32; const bool act = idx < cnt;
    const int ent = act ? ((const int*)(ws + WS_LIST))[(size_t)lid * 8192 + idx] : 0;
    const int t = ent & 0xffff, rank = ent >> 16;
    const bf16_t* Q = (const bf16_t*)(ws + WS_MQ) + ((size_t)(b * NT + t) * 8 + h) * HD + hw * 8;
    bf16x8 qr[8];
#pragma unroll
    for (int d0 = 0; d0 < 8; ++d0) qr[d0] = *(const bf16x8*)(Q + 16 * d0);
    const float slope2 = __int_as_float(__builtin_amdgcn_readfirstlane(__float_as_int(exp2f(-((float)h + 0.5f)) * LOG2E)));
    float m = MINIT, l = 0.f; f32x16 o[4]; zero_o(o);
    const bf16_t* Kb = (const bf16_t*)(ws + WS_MK) + ((size_t)(b * NT + j * 256) * 8 + h) * HD;
    const bf16_t* Vb = (const bf16_t*)(ws + WS_MV) + ((size_t)(b * NT + j * 256) * 8 + h) * HD;
    Stage st; stage_load(st, Kb, Vb, 1024, tid >> 4, (tid & 15) * 8);
#pragma unroll
    for (int kt = 0; kt < 4; ++kt) {
        int tz = tid; asm volatile("" : "+v"(tz));
        const int lz = tz & 63, r32z = lz & 31, hwz = lz >> 5, srz = tz >> 4, scz = (tz & 15) * 8;
        LAS unsigned char* buf = P.lds + (kt & 1) * BUF_BYTES;
        stage_write(st, buf, srz, scz);
        __syncthreads();
        if (kt + 1 < 4) stage_load(st, Kb + (size_t)(64 * (kt + 1)) * 1024, Vb + (size_t)(64 * (kt + 1)) * 1024, 1024, srz, scz);
        {
            f32x16 p0, p1; bf16x8 pa, pb, pc, pd;
            qk_tile(p0, p1, buf, qr, r32z, hwz, slope2, act ? slope2 * (float)(256 * j + 64 * kt + 4 * hwz - t) : MASKV);
            softmax_tile<false>(p0, p1, m, l, o, 0, 0, pa, pb, pc, pd);
            pv_tile(o, v_rd_base(buf + KT_BYTES, lz), pa, pb, pc, pd);
        }
    }
    if (act) { int tz = tid; asm volatile("" : "+v"(tz)); moba_store_partial(P, b, t, h, rank, o, m, l, (tz & 63) >> 5); }
    __syncthreads();
}
DI void moba_combine(const PArgs& P) {
    const int gw = P.wg * NWAVES + P.wave, NGW = P.G * NWAVES, lane = P.lane, h = lane >> 3, dc = lane & 7;
    const bf16_t* Op = (const bf16_t*)P.out; const f32x2* ML = (const f32x2*)(P.ws + WS_ML); bf16_t* hb = (bf16_t*)(P.ws + WS_HB);
    for (int tok = gw; tok < NTOK; tok += NGW) {
        const size_t pi = ((size_t)tok * 8 + h) * 4;
        f32x2 ml[4]; float M = MINIT;
#pragma unroll
        for (int r = 0; r < 4; ++r) { ml[r] = ML[pi + r]; M = fmaxf(M, ml[r].x); }
        float w[4], ws_ = 0.f;
#pragma unroll
        for (int r = 0; r < 4; ++r) { w[r] = ml[r].y * __builtin_amdgcn_exp2f(ml[r].x - M); ws_ += w[r]; }
        const float inv = ws_ > 0.f ? 1.0f / ws_ : 0.f;
        float acc[16];
#pragma unroll
        for (int i = 0; i < 16; ++i) acc[i] = 0.f;
#pragma unroll
        for (int r = 0; r < 4; ++r) {
            const u32x4* p = (const u32x4*)(Op + (pi + r) * HD + dc * 16); const u32x4 a = p[0], c = p[1]; const float wr_ = w[r] * inv;
            if (w[r] > 0.f) {
                acc[0] += wr_ * bflo(a.x); acc[1] += wr_ * bfhi(a.x); acc[2] += wr_ * bflo(a.y); acc[3] += wr_ * bfhi(a.y); acc[4] += wr_ * bflo(a.z); acc[5] += wr_ * bfhi(a.z); acc[6] += wr_ * bflo(a.w); acc[7] += wr_ * bfhi(a.w);
                acc[8] += wr_ * bflo(c.x); acc[9] += wr_ * bfhi(c.x); acc[10] += wr_ * bflo(c.y); acc[11] += wr_ * bfhi(c.y); acc[12] += wr_ * bflo(c.z); acc[13] += wr_ * bfhi(c.z); acc[14] += wr_ * bflo(c.w); acc[15] += wr_ * bfhi(c.w);
            }
        }
        float ss = 0.f;
#pragma unroll
        for (int i = 0; i < 16; ++i) ss += acc[i] * acc[i];
        ss = wave_sum(ss);
        const float rs = 1.0f / sqrtf(ss * (1.0f / 1024.f) + EPS);
        u32x4 o0, o1;
#if F8G3
        { u32x4 o8; o8.x = pk4_f8(acc[0] * rs, acc[1] * rs, acc[2] * rs, acc[3] * rs); o8.y = pk4_f8(acc[4] * rs, acc[5] * rs, acc[6] * rs, acc[7] * rs); o8.z = pk4_f8(acc[8] * rs, acc[9] * rs, acc[10] * rs, acc[11] * rs); o8.w = pk4_f8(acc[12] * rs, acc[13] * rs, acc[14] * rs, acc[15] * rs);
          *(u32x4*)(P.ws + WS_HB8 + (size_t)tok * DM + h * HD + dc * 16) = o8; (void)hb; }
#else
        o0.x = pk2(acc[0] * rs, acc[1] * rs); o0.y = pk2(acc[2] * rs, acc[3] * rs); o0.z = pk2(acc[4] * rs, acc[5] * rs); o0.w = pk2(acc[6] * rs, acc[7] * rs);
        o1.x = pk2(acc[8] * rs, acc[9] * rs); o1.y = pk2(acc[10] * rs, acc[11] * rs); o1.z = pk2(acc[12] * rs, acc[13] * rs); o1.w = pk2(acc[14] * rs, acc[15] * rs);
        u32x4* dst = (u32x4*)(hb + (size_t)tok * DM + h * HD + dc * 16); dst[0] = o0; dst[1] = o1;
#endif
    }
}
}
namespace att {
DI float dpp_quad_sum(float v) {
    int x = __float_as_int(v);
    v += __int_as_float(__builtin_amdgcn_mov_dpp(x, 0xB1, 0xf, 0xf, true));
    x = __float_as_int(v);
    v += __int_as_float(__builtin_amdgcn_mov_dpp(x, 0x4E, 0xf, 0xf, true));
    return v;
}
DI void lds_addf(LAS float* p, float v) { (void)__hip_atomic_fetch_add(p, v, __ATOMIC_RELAXED, __HIP_MEMORY_SCOPE_WORKGROUP); }

DI void nsa_unit(const PArgs& P, int b, int g, int c) {
    int tid = P.tid; asm volatile("" : "+v"(tid));
    const int lane = tid & 63, wave = P.wave, r32 = lane & 31, hw = lane >> 5;
    unsigned char* ws = P.ws;
    const int t0 = 64 * c, tl = wave * 8 + (r32 >> 2), t = t0 + tl, head = g * 4 + (r32 & 3);
    const bf16_t* Q = (const bf16_t*)(ws + WS_NQ) + ((size_t)(b * NT + t) * 8 + head) * HD + hw * 8;
    bf16x8 qr[8];
#pragma unroll
    for (int d0 = 0; d0 < 8; ++d0) qr[d0] = *(const bf16x8*)(Q + 16 * d0);
    const float slope2 = exp2f(-(float)(head + 1)) * LOG2E;
    const float* gp = (const float*)(ws + WS_GATES) + (size_t)(b * NT + t) * 24 + head * 3;
    const float g0 = gp[0], g1 = gp[1], g2 = gp[2];
    bf16_t* orow = (bf16_t*)(ws + WS_HB) + (size_t)(b * NT + t) * DM + 1024 + head * HD;
    LAS float* imp = (LAS float*)(P.lds + SCR_OFF);
    LAS unsigned* selm = (LAS unsigned*)(P.lds + SCR_OFF + 32768);
    LAS unsigned* uni = selm + 256;
    LAS int* blist = (LAS int*)(uni + 4);
    for (int i = tid; i < 64 * 128; i += NTHR) imp[i] = 0.f;
    if (tid < 4) uni[tid] = 0u;
    const int sr = tid >> 4, sc = (tid & 15) * 8;
    const size_t slab = (size_t)(b * 2 + g);
    float m = MINIT, l = 0.f; f32x16 o[4];
    {
        const bf16_t* Kb = (const bf16_t*)(ws + WS_KCMP) + slab * 512 * HD; const bf16_t* Vb = (const bf16_t*)(ws + WS_VCMP) + slab * 512 * HD;
        const int nkeys = (4 * c + 3) < 511 ? (4 * c + 3) : 511, ntl = (nkeys + 63) >> 6;
        const int nlim = t >= 31 ? ((t - 31) >> 4) : -1;
        const float ksc = slope2 * 16.f, b0 = slope2 * (float)(31 - t);
        Stage st; stage_load(st, Kb, Vb, HD, sr, sc);
        for (int ti = 0; ti < ntl; ++ti) {
            LAS unsigned char* buf = P.lds + (ti & 1) * BUF_BYTES;
            stage_write(st, buf, sr, sc);
            __syncthreads();
            if (ti + 1 < ntl) stage_load(st, Kb + (size_t)(64 * (ti + 1)) * HD, Vb + (size_t)(64 * (ti + 1)) * HD, HD, sr, sc);
            f32x16 p0, p1; qk_tile(p0, p1, buf, qr, r32, hw, ksc, ksc * (float)(64 * ti + 4 * hw) + b0);
            const float mx = half_max(mask_max<true>(p0, p1, -1000 - 4 * hw, nlim - 64 * ti - 4 * hw));
            const float mn = fmaxf(m, mx);
            float ps = 0.f;
#pragma unroll
            for (int r = 0; r < 16; ++r) ps += __builtin_amdgcn_exp2f(p0[r] - mn) + __builtin_amdgcn_exp2f(p1[r] - mn);
            l = l * __builtin_amdgcn_exp2f(m - mn) + half_sum(ps); m = mn;
        }
        __syncthreads();
        const float invl = l > 0.f ? 1.0f / l : 0.f;
        zero_o(o);
        stage_load(st, Kb, Vb, HD, sr, sc);
        for (int ti = 0; ti < ntl; ++ti) {
            LAS unsigned char* buf = P.lds + (ti & 1) * BUF_BYTES;
            stage_write(st, buf, sr, sc);
            __syncthreads();
            if (ti + 1 < ntl) stage_load(st, Kb + (size_t)(64 * (ti + 1)) * HD, Vb + (size_t)(64 * (ti + 1)) * HD, HD, sr, sc);
            f32x16 p0, p1; qk_tile(p0, p1, buf, qr, r32, hw, ksc, ksc * (float)(64 * ti + 4 * hw) + b0);
            (void)mask_max<true>(p0, p1, -1000 - 4 * hw, nlim - 64 * ti - 4 * hw);
#pragma unroll
            for (int r = 0; r < 16; ++r) { p0[r] = __builtin_amdgcn_exp2f(p0[r] - m) * invl; p1[r] = __builtin_amdgcn_exp2f(p1[r] - m) * invl; }
#pragma unroll
            for (int hf = 0; hf < 2; ++hf)
#pragma unroll
                for (int gq = 0; gq < 4; ++gq) {
                    const f32x16& pp = hf ? p1 : p0;
                    float s4 = (pp[4 * gq] + pp[4 * gq + 1]) + (pp[4 * gq + 2] + pp[4 * gq + 3]), s1 = pp[4 * gq + 3];
                    s4 = dpp_quad_sum(s4); s1 = dpp_quad_sum(s1);
                    const int sblk = 16 * ti + 8 * hf + 2 * gq + hw;
                    if ((r32 & 3) == 0) { lds_addf(imp + tl * 128 + sblk, s4); if (sblk + 1 < 128) lds_addf(imp + tl * 128 + sblk + 1, s1); }
                }
            const bf16x8 pa = pack_half(p0, 0), pb = pack_half(p0, 1), pc = pack_half(p1, 0), pd = pack_half(p1, 1);
            pv_tile(o, v_rd_base(buf + KT_BYTES, lane), pa, pb, pc, pd);
        }
        store_o(orow, o, g0, hw, false);
    }
    __syncthreads();
    {
        for (int tk = 0; tk < 8; ++tk) {
            const int tok = wave * 8 + tk;
            unsigned long long m0, m1;
            if (c + 1 <= 16) { m0 = (c >= 63) ? ~0ull : ((1ull << (c + 1)) - 1ull); m1 = 0ull; }
            else {
                const int s0 = lane, s1 = lane + 64;
                const bool c0 = (s0 >= 1 && s0 <= c - 2), c1 = (s1 <= c - 2);
                const unsigned k0 = c0 ? __float_as_uint(imp[tok * 128 + s0]) : 0u, k1 = c1 ? __float_as_uint(imp[tok * 128 + s1]) : 0u;
                const int R = 13;
                unsigned thr = 0u;
                for (int bit = 31; bit >= 0; --bit) {
                    const unsigned tt = thr | (1u << bit);
                    const int cn = __builtin_popcountll(__builtin_amdgcn_ballot_w64(c0 && k0 >= tt)) + __builtin_popcountll(__builtin_amdgcn_ballot_w64(c1 && k1 >= tt));
                    if (cn >= R) thr = tt;
                }
                const unsigned long long gt0 = __builtin_amdgcn_ballot_w64(c0 && k0 > thr), gt1 = __builtin_amdgcn_ballot_w64(c1 && k1 > thr);
                const unsigned long long eq0 = __builtin_amdgcn_ballot_w64(c0 && k0 == thr), eq1 = __builtin_amdgcn_ballot_w64(c1 && k1 == thr);
                int need = R - (__builtin_popcountll(gt0) + __builtin_popcountll(gt1));
                unsigned long long e0 = eq0, e1 = eq1, t0m = 0ull, t1m = 0ull;
                const int n0 = __builtin_popcountll(e0);
                if (need >= n0) { t0m = e0; need -= n0; } else { while (need > 0) { const unsigned long long low = e0 & (0ull - e0); t0m |= low; e0 ^= low; --need; } }
                if (need > 0) { while (need > 0 && e1) { const unsigned long long low = e1 & (0ull - e1); t1m |= low; e1 ^= low; --need; } }
                m0 = gt0 | t0m; m1 = gt1 | t1m;
                m0 |= 1ull;
                if (c < 64) m0 |= 1ull << c; else m1 |= 1ull << (c - 64);
                if (c - 1 < 64) m0 |= 1ull << (c - 1); else m1 |= 1ull << (c - 1 - 64);
            }
            if (lane == 0) {
                selm[tok * 4 + 0] = (unsigned)m0; selm[tok * 4 + 1] = (unsigned)(m0 >> 32); selm[tok * 4 + 2] = (unsigned)m1; selm[tok * 4 + 3] = (unsigned)(m1 >> 32);
                (void)__hip_atomic_fetch_or(uni + 0, (unsigned)m0, __ATOMIC_RELAXED, __HIP_MEMORY_SCOPE_WORKGROUP); (void)__hip_atomic_fetch_or(uni + 1, (unsigned)(m0 >> 32), __ATOMIC_RELAXED, __HIP_MEMORY_SCOPE_WORKGROUP);
                (void)__hip_atomic_fetch_or(uni + 2, (unsigned)m1, __ATOMIC_RELAXED, __HIP_MEMORY_SCOPE_WORKGROUP); (void)__hip_atomic_fetch_or(uni + 3, (unsigned)(m1 >> 32), __ATOMIC_RELAXED, __HIP_MEMORY_SCOPE_WORKGROUP);
            }
        }
    }
    __syncthreads();
    if (tid == 0) { int n = 0; for (int w = 0; w < 4; ++w) { unsigned u = uni[w]; while (u) { const int bpos = __builtin_ctz(u); blist[n++] = 32 * w + bpos; u &= u - 1u; } } blist[128] = n; }
    __syncthreads();
    const unsigned my0 = selm[tl * 4 + 0], my1 = selm[tl * 4 + 1], my2 = selm[tl * 4 + 2], my3 = selm[tl * 4 + 3];
#define NSA_STEP(IDX, HAVE_NEXT, KNEXT, VNEXT, MASKED, LO, HI, JPOS, ON) do { \
        LAS unsigned char* buf = P.lds + ((IDX) & 1) * BUF_BYTES; \
        stage_write(st, buf, sr, sc); \
        __syncthreads(); \
        if (HAVE_NEXT) stage_load(st, (KNEXT), (VNEXT), HD, sr, sc); \
        if (__builtin_amdgcn_ballot_w64(ON) != 0ull) {     \
        f32x16 p0, p1; bf16x8 pa, pb, pc, pd; \
        qk_tile(p0, p1, buf, qr, r32, hw, slope2, (ON) ? slope2 * (float)(64 * (JPOS) + 4 * hw - t) : MASKV); \
        softmax_tile<MASKED>(p0, p1, m, l, o, (LO), (HI), pa, pb, pc, pd); \
        pv_tile(o, v_rd_base(buf + KT_BYTES, lane), pa, pb, pc, pd); } } while (0)
    {
        const bf16_t* Kb = (const bf16_t*)(ws + WS_KS) + slab * NT * HD; const bf16_t* Vb = (const bf16_t*)(ws + WS_VS) + slab * NT * HD;
        const int nb = blist[128];
        m = MINIT; l = 0.f; zero_o(o);
        Stage st; { const int j0 = blist[0]; stage_load(st, Kb + (size_t)(64 * j0) * HD, Vb + (size_t)(64 * j0) * HD, HD, sr, sc); }
        for (int bi = 0; bi + 1 < nb; ++bi) {
            const int j = blist[bi], jn = blist[bi + 1];
            const unsigned wsel = (j < 32) ? my0 : (j < 64) ? my1 : (j < 96) ? my2 : my3;
            const bool on = (wsel >> (j & 31)) & 1u;
            NSA_STEP(bi, true, Kb + (size_t)(64 * jn) * HD, Vb + (size_t)(64 * jn) * HD, false, 0, 0, j, on);
        }
        NSA_STEP(nb - 1, false, Kb, Vb, true, -1000 - 4 * hw, tl - 4 * hw, c, true);
        store_o(orow, o, l > 0.f ? g1 / l : 0.f, hw, true);
    }
    __syncthreads();
    {
        const bf16_t* Kb = (const bf16_t*)(ws + WS_KW) + slab * NT * HD; const bf16_t* Vb = (const bf16_t*)(ws + WS_VW) + slab * NT * HD;
        m = MINIT; l = 0.f; zero_o(o);
        int idx = 0;
        const int jfirst = c >= 8 ? c - 8 : 0;
        Stage st; stage_load(st, Kb + (size_t)(64 * jfirst) * HD, Vb + (size_t)(64 * jfirst) * HD, HD, sr, sc);
        if (c >= 8) { NSA_STEP(idx, true, Kb + (size_t)(64 * (c - 7)) * HD, Vb + (size_t)(64 * (c - 7)) * HD, true, tl + 1 - 4 * hw, 1000, c - 8, true); ++idx; }
        for (int j = (c >= 8 ? c - 7 : 0); j < c; ++j) { NSA_STEP(idx, true, Kb + (size_t)(64 * (j + 1)) * HD, Vb + (size_t)(64 * (j + 1)) * HD, false, 0, 0, j, true); ++idx; }
        NSA_STEP(idx, false, Kb, Vb, true, -1000 - 4 * hw, tl - 4 * hw, c, true);
        store_o(orow, o, l > 0.f ? g2 / l : 0.f, hw, true);
    }
#undef NSA_STEP
    __syncthreads();
}
}
DI void kmean_items(const PArgs& P, int w0, int nw) {
    const bf16_t* mk = (const bf16_t*)(P.ws + WS_MK); bf16_t* km = (bf16_t*)(P.ws + WS_KMEAN);
    for (int it = w0; it < NB * 8 * 32; it += nw) {
        const int b = it >> 8, h = (it >> 5) & 7, blk = it & 31;
        const unsigned* src = (const unsigned*)(mk + ((size_t)(b * NT + blk * 256) * 8 + h) * HD) + P.lane;
        float s0 = 0.f, s1 = 0.f;
#pragma unroll 8
        for (int k = 0; k < 256; ++k) { const unsigned u = src[(size_t)k * 512]; s0 += bflo(u); s1 += bfhi(u); }
        ((unsigned*)(km + (size_t)it * HD))[P.lane] = pk2(s0 * (1.0f / 256.f), s1 * (1.0f / 256.f));
    }
}
DI float gelu_tanh(float x) { const float u = 0.7978845608028654f * (x + 0.044715f * x * x * x); const float e = __expf(2.f * u); return 0.5f * x * (1.f + (1.f - 2.f / (1.f + e))); }
DI void compress2_items(const PArgs& P) {
    const int gw = P.wg * NWAVES + P.wave, NGW = P.G * NWAVES, lane = P.lane;
    LAS float* w2s = (LAS float*)P.lds;
    LAS float* hid = (LAS float*)(P.lds + 65536 + P.wave * 512);
    for (int kv = 0; kv < 2; ++kv) {
        { const f32x4* w2 = (const f32x4*)INP(kv ? I_W2V : I_W2K);
          for (int i = P.tid; i < 128 * 128 / 4; i += NTHR) *(LAS f32x4*)(w2s + 4 * i) = w2[i]; }
        __syncthreads();
        const float* Pm = (const float*)(P.ws + (kv ? WS_PV : WS_PK)); const float* bias = (const float*)(P.ws + WS_BIAS) + kv * 128;
        for (int row = gw; row < 4096; row += NGW) {
            const int c = row & 511;
            bf16_t* dst = (bf16_t*)(P.ws + (kv ? WS_VCMP : WS_KCMP)) + (size_t)row * HD;
            if (c == 511) { ((unsigned*)dst)[lane] = 0u; continue; }
            const float h0 = gelu_tanh(Pm[(size_t)row * 256 + lane] + Pm[(size_t)(row + 1) * 256 + 128 + lane] + bias[lane]);
            const float h1 = gelu_tanh(Pm[(size_t)row * 256 + 64 + lane] + Pm[(size_t)(row + 1) * 256 + 192 + lane] + bias[64 + lane]);
            hid[lane] = h0; hid[64 + lane] = h1;
            LDS_WAIT();
            float a0 = 0.f, a1 = 0.f;
#pragma unroll 16
            for (int n = 0; n < 128; ++n) { const float hv = hid[n]; const f32x2 w = *(const LAS f32x2*)(w2s + n * HD + 2 * lane); a0 = fmaf(hv, w.x, a0); a1 = fmaf(hv, w.y, a1); }
            ((unsigned*)dst)[lane] = pk2(a0, a1);
            LDS_WAIT();
        }
        __syncthreads();
    }
}
DI void outnorm_rows(const PArgs& P) {
    const int gw = P.wg * NWAVES + P.wave, NGW = P.G * NWAVES, lane = P.lane;
    bf16_t* hb = (bf16_t*)(P.ws + WS_HB);
    for (int row = gw; row < NTOK; row += NGW) {
        for (int grp = 1; grp < 2; ++grp) {
            u32x4* p = (u32x4*)(hb + (size_t)row * DM + grp * 1024) + lane;
            u32x4 a = p[0], c = p[64]; float v[16];
            v[0] = bflo(a.x); v[1] = bfhi(a.x); v[2] = bflo(a.y); v[3] = bfhi(a.y); v[4] = bflo(a.z); v[5] = bfhi(a.z); v[6] = bflo(a.w); v[7] = bfhi(a.w);
            v[8] = bflo(c.x); v[9] = bfhi(c.x); v[10] = bflo(c.y); v[11] = bfhi(c.y); v[12] = bflo(c.z); v[13] = bfhi(c.z); v[14] = bflo(c.w); v[15] = bfhi(c.w);
            float s = 0.f;
#pragma unroll
            for (int i = 0; i < 16; ++i) s += v[i] * v[i];
            s = wave_sum(s);
            const float rs = 1.0f / sqrtf(s * (1.0f / 1024.f) + EPS);
            a.x = pk2(v[0] * rs, v[1] * rs); a.y = pk2(v[2] * rs, v[3] * rs); a.z = pk2(v[4] * rs, v[5] * rs); a.w = pk2(v[6] * rs, v[7] * rs);
            c.x = pk2(v[8] * rs, v[9] * rs); c.y = pk2(v[10] * rs, v[11] * rs); c.z = pk2(v[12] * rs, v[13] * rs); c.w = pk2(v[14] * rs, v[15] * rs);
#if F8G3
            { unsigned char* q8 = P.ws + WS_HB8 + (size_t)row * DM + grp * 1024 + 8 * lane; u32x2 w0, w1;
              w0.x = pk4_f8(v[0] * rs, v[1] * rs, v[2] * rs, v[3] * rs); w0.y = pk4_f8(v[4] * rs, v[5] * rs, v[6] * rs, v[7] * rs); w1.x = pk4_f8(v[8] * rs, v[9] * rs, v[10] * rs, v[11] * rs); w1.y = pk4_f8(v[12] * rs, v[13] * rs, v[14] * rs, v[15] * rs);
              *(u32x2*)q8 = w0; *(u32x2*)(q8 + 512) = w1; }
#else
            p[0] = a; p[64] = c;
#endif
        }
    }
}
DI void router_tasks(const PArgs& P) {
    const int lane = P.lane, fr = lane & 15, fq = lane >> 4;
    unsigned char* ws = P.ws;
    const bf16_t* xb1 = (const bf16_t*)P.out; const bf16_t* wr = (const bf16_t*)(ws + WS_WR);
    const float* ssq1 = (const float*)(ws + WS_CTL + CTL_SSQ1); float* rs1 = (float*)(ws + WS_RS1);
    unsigned* cnt = (unsigned*)(ws + WS_CTL) + CTLW_CNT; int* tokl = (int*)(ws + WS_TOKL); float* asgw = (float*)(ws + WS_WL); float* rsl = (float*)(ws + WS_RSL); int* asg = (int*)(ws + WS_ASG);
    const float* rbias = INP(I_RBIAS);
    LAS float* la = (LAS float*)(P.lds + P.wave * 8448);
    LAS float* lb = la + 16 * 66;
    LAS unsigned* lcnt = (LAS unsigned*)(P.lds + NWAVES * 8448);
    LAS unsigned* lbase = lcnt + 64;
    for (int task0 = P.wg * NWAVES; task0 < NTOK / 16; task0 += P.G * NWAVES) {
        const int t0 = (task0 + P.wave) * 16;
        if (P.tid < 64) lcnt[P.tid] = 0u;
        f32x4 acc[4];
#pragma unroll
        for (int n = 0; n < 4; ++n) acc[n] = (f32x4){0.f, 0.f, 0.f, 0.f};
        const bf16_t* ap = xb1 + (size_t)(t0 + fr) * DM + fq * 8; const bf16_t* bp = wr + (size_t)fr * DM + fq * 8;
#pragma unroll 4
        for (int kk = 0; kk < 64; ++kk) {
            const bf16x8 a = *(const bf16x8*)(ap + 32 * kk);
#pragma unroll
            for (int n = 0; n < 4; ++n) { const bf16x8 bb = *(const bf16x8*)(bp + (size_t)(16 * n) * DM + 32 * kk); acc[n] = __builtin_amdgcn_mfma_f32_16x16x32_bf16(a, bb, acc[n], 0, 0, 0); }
        }
#pragma unroll
        for (int n = 0; n < 4; ++n)
#pragma unroll
            for (int j = 0; j < 4; ++j) la[(4 * fq + j) * 66 + 16 * n + fr] = acc[n][j];
        __syncthreads();
        int sel[8]; unsigned ls[8]; float wv[8]; float rs = 0.f;
#pragma unroll
        for (int r = 0; r < 8; ++r) { sel[r] = 0; ls[r] = 0u; wv[r] = 0.f; }
        if (lane < 16) {
            const int t = t0 + lane; LAS float* A = la + lane * 66; LAS float* Bv = lb + lane * 66;
            rs = 1.0f / sqrtf(ssq1[t] * (1.0f / DM) + EPS); rs1[t] = rs;
            for (int e = 0; e < 64; ++e) { const float a = 1.0f / (1.0f + __expf(-rs * A[e])); A[e] = a; Bv[e] = a + rbias[e]; }
            float gs[8];
#pragma unroll
            for (int gi = 0; gi < 8; ++gi) { float m1 = -1e30f, m2 = -1e30f; for (int k = 0; k < 8; ++k) { const float v = Bv[8 * gi + k]; if (v > m1) { m2 = m1; m1 = v; } else if (v > m2) m2 = v; } gs[gi] = m1 + m2; }
            unsigned gmask = 0u;
            for (int r = 0; r < 4; ++r) { float best = -1e30f; int bi = 0;
#pragma unroll
                for (int gi = 0; gi < 8; ++gi) { const bool ok = !((gmask >> gi) & 1u) && gs[gi] > best; if (ok) { best = gs[gi]; bi = gi; } }
                gmask |= 1u << bi; }
            unsigned long long taken = 0ull; float wsum = 0.f;
#pragma unroll
            for (int r = 0; r < 8; ++r) { float best = -1e30f; int bi = 0;
                for (int e = 0; e < 64; ++e) { const bool ok = ((gmask >> (e >> 3)) & 1u) && !((taken >> e) & 1ull) && Bv[e] > best; if (ok) { best = Bv[e]; bi = e; } }
                taken |= 1ull << bi; sel[r] = bi; wv[r] = A[bi]; wsum += A[bi]; }
            const float wn = 2.5f / wsum;
#pragma unroll
            for (int r = 0; r < 8; ++r) { wv[r] *= wn; ls[r] = __hip_atomic_fetch_add(lcnt + sel[r], 1u, __ATOMIC_RELAXED, __HIP_MEMORY_SCOPE_WORKGROUP); }
        }
        __syncthreads();
        if (P.tid < 64) { const unsigned c = lcnt[P.tid]; lbase[P.tid] = c ? atomicAdd(cnt + P.tid, c) : 0u; }
        __syncthreads();
        if (lane < 16) {
            const int t = t0 + lane;
#pragma unroll
            for (int r = 0; r < 8; ++r) { const int e = sel[r]; const unsigned slot = (lbase[e] + ls[r]) & 32767u; const size_t li = (size_t)e * 32768 + slot;
                tokl[li] = t; rsl[li] = rs; asg[t * 8 + r] = (e << 15) | (int)slot; asgw[t * 8 + r] = wv[r]; }
        }
    }
    __syncthreads();
}
DI void moe_tables(const PArgs& P, LAS int* tab) {
    if (P.wave == 0) {
        const unsigned* cnt = (const unsigned*)(P.ws + WS_CTL) + CTLW_CNT; const int e = P.lane;
        const int ce = (int)__hip_atomic_load(cnt + e, __ATOMIC_RELAXED, __HIP_MEMORY_SCOPE_AGENT); const int mt = (ce + 255) >> 8;
        int inc = mt;
#pragma unroll
        for (int o = 1; o < 64; o <<= 1) { const int v = __shfl_up(inc, o); if (e >= o) inc += v; }
        const int mo = inc - mt;
        tab[e] = ce; tab[80 + e] = mo; tab[160 + e] = mo * 256;
        if (e == 63) { tab[64] = NTOK; tab[80 + 64] = inc; tab[160 + 64] = PSH; tab[80 + 65] = inc + NTOK / 256; }
    }
    __syncthreads();
}
DI void combine_rows(const PArgs& P, const LAS int* tab, float ysc, int gw, int NGW) {
    const int lane = P.lane;
    const bf16_t* xres = (const bf16_t*)P.out; const unsigned char* Yp = P.ws + WS_YP; const int* asg = (const int*)(P.ws + WS_ASG); const float* asgw = (const float*)(P.ws + WS_WL);
    float* rs2 = (float*)(P.ws + WS_RS2);
    for (int t = gw; t < NTOK; t += NGW) {
        unsigned rows[8]; float wk[8];
#pragma unroll
        for (int k = 0; k < 8; ++k) { const int a = asg[t * 8 + k]; { const unsigned R = (unsigned)(tab[160 + (a >> 15)] + (a & 32767)); rows[k] = (R >> 8) * 524288u + (R & 255u) * 256u; }   wk[k] = ysc * asgw[t * 8 + k]; }
        float ss = 0.f;
#pragma unroll
        for (int j = 0; j < 2; ++j) {
            const int cl = j * 1024 + 16 * lane;
            const int a0 = (cl & ~255) + ((cl >> 6) & 3) * 32 + ((cl >> 4) & 3) * 8;
            const u32x4* xp = (const u32x4*)(xres + (size_t)t * DM + a0); u32x4* xo = (u32x4*)((bf16_t*)(P.ws + WS_X2B) + (size_t)t * DM + a0);
            const u32x4 xa = xp[0], xb = xp[16];
            float v[16] = {bflo(xa.x), bfhi(xa.x), bflo(xa.y), bfhi(xa.y), bflo(xa.z), bfhi(xa.z), bflo(xa.w), bfhi(xa.w), bflo(xb.x), bfhi(xb.x), bflo(xb.y), bfhi(xb.y), bflo(xb.z), bfhi(xb.z), bflo(xb.w), bfhi(xb.w)};
#pragma unroll
            for (int k = 0; k < 8; ++k) { const u32x4 y = *(const u32x4*)(Yp + rows[k] + (unsigned)((cl >> 8) * 65536 + (cl & 255))); const float w = wk[k];
#pragma unroll
                for (int q = 0; q < 4; ++q) { const f32x2 lo2 = __builtin_amdgcn_cvt_pk_f32_fp8(y[q], false), hi2 = __builtin_amdgcn_cvt_pk_f32_fp8(y[q], true);
                    v[4 * q] += w * lo2[0]; v[4 * q + 1] += w * lo2[1]; v[4 * q + 2] += w * hi2[0]; v[4 * q + 3] += w * hi2[1]; } }
            u32x4 oa, ob;
            oa.x = pk2(v[0], v[1]); oa.y = pk2(v[2], v[3]); oa.z = pk2(v[4], v[5]); oa.w = pk2(v[6], v[7]); ob.x = pk2(v[8], v[9]); ob.y = pk2(v[10], v[11]); ob.z = pk2(v[12], v[13]); ob.w = pk2(v[14], v[15]);
            xo[0] = oa; xo[16] = ob;
#if F8PLE
            { u32x2 o8a, o8b; o8a.x = pk4_f8(v[0], v[1], v[2], v[3]); o8a.y = pk4_f8(v[4], v[5], v[6], v[7]); o8b.x = pk4_f8(v[8], v[9], v[10], v[11]); o8b.y = pk4_f8(v[12], v[13], v[14], v[15]);
              unsigned char* x8 = P.ws + WS_X28 + (size_t)t * DM + a0; *(u32x2*)x8 = o8a; *(u32x2*)(x8 + 128) = o8b; }
#endif
#pragma unroll
            for (int q = 0; q < 16; ++q) ss += v[q] * v[q];
        }
        ss = wave_sum(ss);
        if (lane == 0) rs2[t] = 1.0f / sqrtf(ss * (1.0f / DM) + EPS);
    }
}
DI void gates_tasks(const PArgs& P, int w0, int nw) {
    const int lane = P.lane, fr = lane & 15, fq = lane >> 4;
    const bf16_t* xb = (const bf16_t*)(P.ws + WS_HB); const bf16_t* wg = (const bf16_t*)(P.ws + WS_WIN) + (size_t)5632 * DM; float* gates = (float*)(P.ws + WS_GATES);
    for (int task = w0; task < NTOK / 16; task += nw) {
        const int t0 = task * 16;
        f32x4 acc[2] = {(f32x4){0.f, 0.f, 0.f, 0.f}, (f32x4){0.f, 0.f, 0.f, 0.f}};
        const bf16_t* ap = xb + (size_t)(t0 + fr) * DM + fq * 8; const bf16_t* bp = wg + (size_t)fr * DM + fq * 8;
#pragma unroll 4
        for (int kk = 0; kk < 64; ++kk) {
            const bf16x8 a = *(const bf16x8*)(ap + 32 * kk);
#pragma unroll
            for (int n = 0; n < 2; ++n) { const bf16x8 bb = *(const bf16x8*)(bp + (size_t)(16 * n) * DM + 32 * kk); acc[n] = __builtin_amdgcn_mfma_f32_16x16x32_bf16(a, bb, acc[n], 0, 0, 0); }
        }
#pragma unroll
        for (int n = 0; n < 2; ++n)
#pragma unroll
            for (int j = 0; j < 4; ++j) { const int row = t0 + 4 * fq + j, c = 16 * n + fr; if (c < 24) gates[(size_t)row * 24 + c] = 1.0f / (1.0f + __expf(-acc[n][j])); }
    }
}
constexpr int LDS_MISC = 133120, LDS_BYTES = 135168;
constexpr int NPHASE = 16;
static_assert(LDS_MISC + 1024 == 134144 && LDS_MISC + 1024 + 256 <= LDS_BYTES, "MoBA gate counters live at LDS byte 134144");
#ifndef MK_LAUNCHES
#define MK_LAUNCHES 1
#endif

__global__ void __launch_bounds__(NTHR, 2) mega(Args args) {
    extern __shared__ __attribute__((aligned(16))) unsigned char lds_raw[];
    PArgs P;
    P.out = args.out; P.ws = args.ws; P.lds = (LAS unsigned char*)lds_raw;
    P.tid = threadIdx.x; P.lane = P.tid & 63; P.wave = __builtin_amdgcn_readfirstlane(P.tid >> 6); P.G = gridDim.x; P.wg = blockIdx.x;
    volatile LAS unsigned* MISC = (volatile LAS unsigned*)(P.lds + LDS_MISC);
    LAS int* tab = (LAS int*)(P.lds + LDS_MISC + 64);
    if (P.tid < 16) MISC[P.tid] = 0u;
    __syncthreads();
    unsigned char* ws = P.ws;
    const int vcu = (P.G % 8 == 0) ? (P.wg % 8) * (P.G / 8) + P.wg / 8 : P.wg;
    const int lo = args.ph_lo, hi = args.ph_hi;
    const bool fused = (hi - lo) > 1;
    XcdBarrier bar; bar.bar = (unsigned*)(ws + WS_CTL) + CTLW_BAR; bar.x = 0; bar.st = MISC;
    if (fused) bar = xcd_barrier_post((unsigned*)(ws + WS_CTL) + CTLW_BAR, MISC);
#ifndef PH_MASK
#define PH_MASK 0xFFFF
#endif
#define IN(k) (((PH_MASK >> (k)) & 1) && lo <= (k) && (k) < hi)
#define SEAM(k) do { if (IN(k) && IN((k) + 1)) xcd_barrier(bar); { P.lane = lane_id_v(); P.tid = P.wave * 64 + P.lane; { uintptr_t wsi_ = (uintptr_t)ws, oi_ = (uintptr_t)P.out; asm volatile("" : "+s"(wsi_), "+s"(oi_)); ws = (unsigned char*)(GAS unsigned char*)wsi_; P.out = (float*)(GAS float*)oi_; } P.ws = ws; } } while (0)

#define SEAMX(k, kn) do { if (IN(k) && IN(kn)) xcd_barrier(bar); { P.lane = lane_id_v(); P.tid = P.wave * 64 + P.lane; { uintptr_t wsi_ = (uintptr_t)ws, oi_ = (uintptr_t)P.out; asm volatile("" : "+s"(wsi_), "+s"(oi_)); ws = (unsigned char*)(GAS unsigned char*)wsi_; P.out = (float*)(GAS float*)oi_; } P.ws = ws; } } while (0)

#ifndef REP0
#define REP0 1
#endif
#ifndef REP1
#define REP1 1
#endif
#ifndef REP3
#define REP3 1
#endif
#ifndef REP4
#define REP4 1
#endif
#ifndef REP8
#define REP8 1
#endif
#ifndef REP2
#define REP2 1
#endif
#ifndef REP5
#define REP5 1
#endif
#ifndef REP6
#define REP6 1
#endif
#ifndef REP9
#define REP9 1
#endif
#ifndef STAG_TICKS
#define STAG_TICKS 550
#endif
#ifndef REP40
#define REP40 1
#endif
#ifndef REP50
#define REP50 1
#endif
#ifndef GPROBE
#define GPROBE 0
#endif
#ifndef REP14
#define REP14 1
#endif
#ifndef REP15
#define REP15 1
#endif
#ifndef REP10
#define REP10 1
#endif
#ifndef REP13
#define REP13 1
#endif
    if (IN(0)) { for (int rep = 0; rep < REP0; ++rep) { p0_prologue(P); __syncthreads(); } }
    SEAM(0);
    if (IN(1)) {
        pg8::GridOrder S; S.init(NTOK / 256, 22, P.G, P.wg, ws + WS_WIN, DM);
        pg8::EpiProj E{ws, (const float*)(ws + WS_RS0)};
        pg8::gemm_phase<pg8::EpiProj, pg8::GridOrder, false, true>(P.lds, P.wave, (const bf16_t*)(ws + WS_HB), DM, S, E);
#if REP1 == 3
        pg8::gemm_phase<pg8::EpiProj, pg8::GridOrder, false, true>(P.lds, P.wave, (const bf16_t*)(ws + WS_HB), DM, S, E);
#endif
#if REP1 == 2
        { pg8::EpiNull EN; pg8::gemm_phase<pg8::EpiNull, pg8::GridOrder, false, true, GPROBE>(P.lds, P.wave, (const bf16_t*)(ws + WS_HB), DM, S, EN); }
#endif
    }
    SEAM(1);
    if (IN(2)) { kmean_items(P, P.wg * NWAVES + P.wave, P.G * NWAVES); gates_tasks(P, P.wg * NWAVES + P.wave, P.G * NWAVES); }
    SEAM(2);
    if (IN(3)) {
        { pg8::CmpOrder S{P.G, P.wg, (const char*)(ws + WS_W1K), (const char*)(ws + WS_W1V)};
          pg8::EpiF32 E{(float*)(ws + WS_PK), 256};
          pg8::gemm_phase(P.lds, P.wave, (const bf16_t*)(ws + WS_KC), DM, S, E); }
        __syncthreads();
        LAS unsigned* tk3 = (LAS unsigned*)(P.lds + LDS_MISC + 1536);
        unsigned* q3 = (unsigned*)(ws + WS_CTL) + CTLW_Q3;
        for (;;) {
            if (P.tid == 0) *tk3 = atomicAdd(q3, 1u);
            __syncthreads();
            const unsigned T = *tk3;
            __syncthreads();
            if (T >= 1024u) break;
            att::moba_gate_unit(P, (int)(T >> 8), (int)((T >> 5) & 7u), (int)(T & 31u));
        }
    }
    SEAMX(3, 11);
    if (IN(11)) compress2_items(P);
    SEAMX(11, 4);
    if (IN(4)) {
        {
            const bool sub = (P.G % 32) == 0;
            const bool conv = sub ? (((P.wg >> 3) & 3) == 3) : true;
            const int ncw = sub ? P.G / 4 : P.G, cidx = sub ? ((P.wg >> 5) * 8 + (P.wg & 7)) : P.wg;
            if (conv) { conv_expert_items(P, cidx * NWAVES + P.wave, ncw * NWAVES); __syncthreads(); }
        }
        LAS int* pre = (LAS int*)(P.lds + 114688);
        if (P.wave == 0) {
            const unsigned* lcnt = (const unsigned*)(ws + WS_CTL) + CTLW_LCNT; const int l = P.lane;
            int n[16], tot = 0;
#pragma unroll
            for (int k = 0; k < 16; ++k) { n[k] = ((int)__hip_atomic_load(lcnt + 16 * l + k, __ATOMIC_RELAXED, __HIP_MEMORY_SCOPE_AGENT) + 255) >> 8; tot += n[k]; }
            int inc = tot;
#pragma unroll
            for (int o = 1; o < 64; o <<= 1) { const int v = __shfl_up(inc, o); if (l >= o) inc += v; }
            int run = inc - tot;
#pragma unroll
            for (int k = 0; k < 16; ++k) { pre[16 * l + k] = run; run += n[k]; }
            if (l == 63) pre[1024] = run;
        }
        __syncthreads();
        const int NI = pre[1024];
        const unsigned nt4 = 1024u + (unsigned)((NI + 1) >> 1);
        LAS unsigned* tk = (LAS unsigned*)(P.lds + LDS_MISC + 1536);
        unsigned* q4 = (unsigned*)(ws + WS_CTL) + CTLW_Q4;
        for (;;) {
            if (P.tid == 0) *tk = atomicAdd(q4, 1u);
            __syncthreads();
            const unsigned T = *tk;
            __syncthreads();
            if (T >= nt4) break;
            if (T < 1024u) { const int bg = (int)(T & 7u), c = 127 - (int)(T >> 3); att::nsa_unit(P, bg >> 1, bg & 1, c); }
            else {
                const int i0 = (int)(T - 1024u) * 2;
                for (int i = i0; i < i0 + 2 && i < NI; ++i) {
                    int lo_ = 0, hi_ = 1024;
                    while (hi_ - lo_ > 1) { const int mid = (lo_ + hi_) >> 1; if (pre[mid] <= i) lo_ = mid; else hi_ = mid; }
                    att::moba_item(P, lo_, i - pre[lo_]);
                }
            }
        }
    }
    SEAM(4);
    if (IN(5)) { for (int rep = 0; rep < REP50; ++rep) att::moba_combine(P); for (int rep = 0; rep < REP5; ++rep) outnorm_rows(P); }
    SEAM(5);
    if (IN(6)) {
        pg8::GridOrder S; S.init(NTOK / 256, DM / 256, P.G, P.wg, ws + WS_WOUT, F8G3 ? DM / 2 : DM);
        for (int rep = 0; rep < REP6; ++rep) {
        pg8::EpiOut E{INP(I_X), (bf16_t*)P.out, rep == 0 ? (float*)(ws + WS_CTL + CTL_SSQ1) : (float*)(ws + WS_PK), (unsigned char*)P.out + 128 * MiB};
#if F8G3
        pg8::gemm_phase<pg8::EpiOut, pg8::GridOrder, true>(P.lds, P.wave, (const bf16_t*)(ws + WS_HB8), DM / 2, S, E); }
#else
        pg8::gemm_phase(P.lds, P.wave, (const bf16_t*)(ws + WS_HB), DM, S, E); }
#endif
    }
    SEAM(6);
    if (IN(7)) router_tasks(P);
    SEAM(7);
    if (IN(8)) {
        moe_tables(P, tab);
#if F8GU
        pg8::MoeOrder<true> S{P.G, vcu, tab + 80, tab, __builtin_amdgcn_readfirstlane(tab[80 + 65]) * 4, (const char*)(ws + WS_WGU), (size_t)1024 * DM, (size_t)256 * DM, 0, (const int*)(ws + WS_TOKL), true, tab + 160};
        pg8::EpiGU E{ws + WS_H, (const float*)(ws + WS_RSL), (const float*)(ws + WS_RS1), tab + 160};
        for (int rep = 0; rep < REP8; ++rep) pg8::gemm_phase<pg8::EpiGU, pg8::MoeOrder<true>, true>(P.lds, P.wave, (const bf16_t*)((const unsigned char*)P.out + 128 * MiB), DM / 2, S, E);
#else
        pg8::MoeOrder<true> S{P.G, vcu, tab + 80, tab, __builtin_amdgcn_readfirstlane(tab[80 + 65]) * 4, (const char*)(ws + WS_WGU), (size_t)1024 * DM * 2, (size_t)256 * DM * 2, 0, (const int*)(ws + WS_TOKL), true, tab + 160};
        pg8::EpiGU E{ws + WS_H, (const float*)(ws + WS_RSL), (const float*)(ws + WS_RS1), tab + 160};
        for (int rep = 0; rep < REP8; ++rep) pg8::gemm_phase<pg8::EpiGU, pg8::MoeOrder<true>, false>(P.lds, P.wave, (const bf16_t*)P.out, DM, S, E);
#endif
    }
    SEAM(8);
    if (IN(9)) {
        moe_tables(P, tab);
        pg8::MoeOrder<false, 3> S{P.G, vcu, tab + 80, tab, __builtin_amdgcn_readfirstlane(tab[80 + 65]) * 8, (const char*)(ws + WS_WD), (size_t)DM * DE * (F8DN ? 1 : 2), (size_t)256 * DE * (F8DN ? 1 : 2), 0, nullptr, false, tab + 160};
        for (int rep = 0; rep < REP9; ++rep) {
        pg8::EpiDown E{ws + WS_YP, rep == 0 ? (bf16_t*)P.out : (bf16_t*)nullptr, tab + 160};
        pg8::gemm_phase<pg8::EpiDown, pg8::MoeOrder<false, 3>, (F8DN != 0)>(P.lds, P.wave, (const bf16_t*)(ws + WS_H), F8DN ? DE / 2 : DE, S, E); }
    }
    SEAM(9);
    if (IN(10)) {
        moe_tables(P, tab);
        const bool sub = (P.G % 32) == 0;
        const bool ppw = sub && (((P.wg >> 3) & 3) == 3);
        if (!sub) { combine_rows(P, tab, 1.0f / YP_SCALE, P.wg * NWAVES + P.wave, P.G * NWAVES);
                    pg8::GridOrder S; S.init(NTOK / 256, DM / 256, P.G, P.wg, ws + WS_WPLE, PLE); pg8::EpiBf16 E{(bf16_t*)(ws + WS_PP), DM};
                    pg8::gemm_phase(P.lds, P.wave, (const bf16_t*)(ws + WS_PB), PLE, S, E); }
        else if (ppw) { pg8::GridOrder S; S.init(NTOK / 256, DM / 256, P.G / 4, (P.wg >> 5) * 8 + (P.wg & 7), ws + WS_WPLE, PLE); pg8::EpiBf16 E{(bf16_t*)(ws + WS_PP), DM};
                        pg8::gemm_phase(P.lds, P.wave, (const bf16_t*)(ws + WS_PB), PLE, S, E); }
        else { const int ci = (P.wg >> 5) * 24 + ((P.wg >> 3) & 3) * 8 + (P.wg & 7);
               combine_rows(P, tab, 1.0f / YP_SCALE, ci * NWAVES + P.wave, (P.G / 4) * 3 * NWAVES); }
    }
    SEAMX(10, 14);
    if (IN(14)) {
        pg8::RowOrder S{(NTOK / 256) * 8, P.G, vcu, (const char*)(ws + WS_WPG), (size_t)256 * DM * (F8PLE ? 1 : 2)};
        pg8::EpiPleFin E{(const bf16_t*)(ws + WS_X2B), P.out, (const bf16_t*)(ws + WS_PP), (const float*)(ws + WS_RS2), (float*)(ws + WS_CTL + CTL_SSQ3), (unsigned*)(ws + WS_CTL) + CTLW_ARR, INP(I_NFING)};
#if F8PLE
        pg8::gemm_phase<pg8::EpiPleFin, pg8::RowOrder, true>(P.lds, P.wave, (const bf16_t*)(ws + WS_X28), DM / 2, S, E);
#else
        pg8::gemm_phase<pg8::EpiPleFin, pg8::RowOrder, false>(P.lds, P.wave, (const bf16_t*)(ws + WS_X2B), DM, S, E);
#endif
    }
#undef IN
#undef SEAM
}

extern "C" void kernel_launch(void* const* d_in, const int* in_sizes, int n_in, void* d_out, int out_size, void* d_ws, size_t ws_size, hipStream_t stream) {
    static int grid = 0;
    if (grid == 0) {
        if (n_in != 26 || in_sizes[0] != NTOK * DM || out_size != NTOK * DM || ws_size < WS_END) {
            fprintf(stderr, "kernel_launch: unexpected shapes (n_in %d, in0 %d, out %d, ws %zu < %zu); nothing launched\n", n_in, n_in > 0 ? in_sizes[0] : -1, out_size, ws_size, (size_t)WS_END); grid = -1; return; }
        int dev = 0, cus = 0, per_cu = 0;
        if (hipGetDevice(&dev) != hipSuccess || hipDeviceGetAttribute(&cus, hipDeviceAttributeMultiprocessorCount, dev) != hipSuccess) { grid = -1; return; }
        if (hipFuncSetAttribute((const void*)mega, hipFuncAttributeMaxDynamicSharedMemorySize, LDS_BYTES) != hipSuccess) { fprintf(stderr, "kernel_launch: hipFuncSetAttribute failed\n"); grid = -1; return; }
        if (hipOccupancyMaxActiveBlocksPerMultiprocessor(&per_cu, (const void*)mega, NTHR, LDS_BYTES) != hipSuccess || per_cu < 1) { fprintf(stderr, "kernel_launch: occupancy query says %d\n", per_cu); }
        (void)hipGetLastError();
        grid = cus & ~7;
        if (grid < 8) { fprintf(stderr, "kernel_launch: %d CUs\n", cus); grid = -1; return; }
    }
    if (grid < 0) return;
    (void)hipMemsetAsync((char*)d_ws + WS_CTL, 0, CTL_BYTES, stream);
    Args a{};
    for (int i = 0; i < 26; ++i) a.in[i] = (const float*)d_in[i];
    a.out = (float*)d_out; a.ws = (unsigned char*)d_ws;
#if MK_LAUNCHES == 1
    a.ph_lo = 0; a.ph_hi = NPHASE;
    hipLaunchKernelGGL(mega, dim3(grid), dim3(NTHR), LDS_BYTES, stream, a);
#else
    for (int k = 0; k < NPHASE; ++k) { a.ph_lo = k; a.ph_hi = k + 1; hipLaunchKernelGGL(mega, dim3(grid), dim3(NTHR), LDS_BYTES, stream, a); }
#endif
    const hipError_t le = hipPeekAtLastError();
    if (le != hipSuccess) fprintf(stderr, "kernel_launch: launch failed: %s\n", hipGetErrorName(le));
}
```
